# Optimizing an MI355X kernel written in HIP

```python
import jax, jax.numpy as jnp
from jax import lax
import numpy as np

D_MODEL = 1024
BATCH = 4
SEQ = 4096
DEPTH = 2

N_MIXERS = 2
N_CONV_LAYERS = (DEPTH + 1) // 2
N_ATTN_LAYERS = DEPTH // 2
CONV_WIDTH = 3
N_HEADS = 16
HEAD_DIM = D_MODEL // N_HEADS
GRID_W = 64
WIN_H_MAX = 8
WIN_W = 16
D_FF = 4 * D_MODEL
NORM_EPS = 1e-6

kernel_name = "hybrid_shortconv_natten2d_encoder"


def rmsnorm(x, g):
    xf = x.astype(jnp.float32)
    y = xf * lax.rsqrt(jnp.mean(xf * xf, axis=-1, keepdims=True) + NORM_EPS)
    return (y * g.astype(jnp.float32)).astype(x.dtype)


def short_conv_mixer(h, w_in, conv_w, w_out):
    u = h @ w_in
    gate_b, gate_c, v = jnp.split(u, 3, axis=-1)
    z = gate_c * v
    zp = jnp.pad(z, ((0, 0), (1, 1), (0, 0)))
    zc = conv_w[0] * zp[:, :-2] + conv_w[1] * zp[:, 1:-1] + conv_w[2] * zp[:, 2:]
    return (gate_b * zc) @ w_out


def neighborhood_attention_2d(h, w_qkv, rpb, w_o):
    bsz, seq, d = h.shape
    rows = seq // GRID_W
    kh = min(WIN_H_MAX, rows)
    qkv = (h @ w_qkv).reshape(bsz, rows, GRID_W, 3, N_HEADS, HEAD_DIM)
    q = qkv[:, :, :, 0] * (HEAD_DIM ** -0.5)
    k = qkv[:, :, :, 1]
    v = qkv[:, :, :, 2]

    cols = jnp.arange(GRID_W)
    row_start = jnp.clip(jnp.arange(rows) - kh // 2, 0, rows - kh)
    col_start = jnp.clip(cols - WIN_W // 2, 0, GRID_W - WIN_W)
    col_idx = col_start[:, None] + jnp.arange(WIN_W)[None, :]
    col_off = col_idx - cols[:, None] + (WIN_W - 1)
    rpb_cols = rpb[:, :, col_off]

    def row_block(args):
        q_row, r = args
        s = row_start[r]
        k_rows = lax.dynamic_slice_in_dim(k, s, kh, axis=1)
        v_rows = lax.dynamic_slice_in_dim(v, s, kh, axis=1)
        k_nb = k_rows[:, :, col_idx]
        v_nb = v_rows[:, :, col_idx]
        scores = jnp.einsum('bqhd,brqchd->bhqrc', q_row, k_nb).astype(jnp.float32)
        row_off = s + jnp.arange(kh) - r + (WIN_H_MAX - 1)
        bias = jnp.transpose(rpb_cols[:, row_off], (0, 2, 1, 3))
        scores = scores + bias[None].astype(jnp.float32)
        p = jax.nn.softmax(scores.reshape(bsz, N_HEADS, GRID_W, kh * WIN_W), axis=-1)
        p = p.reshape(bsz, N_HEADS, GRID_W, kh, WIN_W).astype(v.dtype)
        return jnp.einsum('bhqrc,brqchd->bqhd', p, v_nb)

    out = lax.map(row_block, (jnp.transpose(q, (1, 0, 2, 3, 4)), jnp.arange(rows)))
    out = jnp.transpose(out, (1, 0, 2, 3, 4)).reshape(bsz, seq, d)
    return out @ w_o


def sqrelu_mlp(h, w_up, w_down):
    a = jax.nn.relu(h @ w_up)
    return (a * a) @ w_down


def setup_inputs(seed: int = 0) -> dict:
    key = jax.random.key(seed)
    ks = jax.random.split(key, 16)
    d = D_MODEL
    f32 = jnp.float32
    nrm = lambda k, shp, s: jax.random.normal(k, shp, f32) * s
    return {
        "x": nrm(ks[0], (BATCH, SEQ, d), 1.0),
        "norm_mix": 1.0 + nrm(ks[1], (DEPTH, d), 0.05),
        "conv_w_in": nrm(ks[2], (N_CONV_LAYERS, d, 3 * d), d ** -0.5),
        "conv_w": nrm(ks[3], (N_CONV_LAYERS, CONV_WIDTH, d), CONV_WIDTH ** -0.5),
        "conv_w_out": nrm(ks[4], (N_CONV_LAYERS, d, d), d ** -0.5),
        "attn_w_qkv": nrm(ks[5], (N_ATTN_LAYERS, d, 3 * d), d ** -0.5),
        "attn_rpb": nrm(ks[6], (N_ATTN_LAYERS, N_HEADS, 2 * WIN_H_MAX - 1, 2 * WIN_W - 1), 0.5),
        "attn_w_o": nrm(ks[7], (N_ATTN_LAYERS, d, d), d ** -0.5),
        "norm_mlp": 1.0 + nrm(ks[8], (DEPTH, d), 0.05),
        "mlp_w_up": nrm(ks[9], (DEPTH, d, D_FF), d ** -0.5),
        "mlp_w_down": nrm(ks[10], (DEPTH, D_FF, d), D_FF ** -0.5),
        "norm_final": 1.0 + nrm(ks[11], (d,), 0.05),
    }


def reference(x, norm_mix, conv_w_in, conv_w, conv_w_out, attn_w_qkv, attn_rpb,
              attn_w_o, norm_mlp, mlp_w_up, mlp_w_down, norm_final):
    for i in range(DEPTH):
        h = rmsnorm(x, norm_mix[i])
        j = i // N_MIXERS
        if i % N_MIXERS == 0:
            x = x + short_conv_mixer(h, conv_w_in[j], conv_w[j], conv_w_out[j])
        else:
            x = x + neighborhood_attention_2d(h, attn_w_qkv[j], attn_rpb[j], attn_w_o[j])
        h = rmsnorm(x, norm_mlp[i])
        x = x + sqrelu_mlp(h, mlp_w_up[i], mlp_w_down[i])
    return rmsnorm(x, norm_final)
```

```cpp
#include <hip/hip_runtime.h>
#include <cstdio>
#include <cstdint>
namespace pg8 {
#define PG8_LAS __attribute__((address_space(3)))
typedef unsigned short bf16_t;
typedef short bf16x8 __attribute__((ext_vector_type(8)));
typedef float f32x4 __attribute__((ext_vector_type(4)));
typedef unsigned u32x4 __attribute__((ext_vector_type(4)));
constexpr int BM = 256, BK = 64, HALF = 128, HTB = HALF * BK * 2  , STAGE_BYTES = 8 * HTB, NXCD = 8, WGM = 8;

__host__ __device__ __forceinline__ int lds_byte(int r, int c) { const int st = (r >> 4) * 2 + (c >> 5), rr = r & 15, cc = c & 31, ob = rr * 64 + cc * 2; return st * 1024 + (ob ^ (((ob >> 9) & 1) << 5)); }
__host__ __device__ __forceinline__ void stage_rc(int b, int& R, int& C) { const int st = b / 1024, sb = b % 1024, swz = sb ^ (((sb >> 9) & 1) << 5); R = (st >> 1) * 16 + swz / 64; C = (st & 1) * 32 + (swz % 64) / 2; }
__host__ __device__ __forceinline__ int perm32(int rho) { const int n = rho >> 4, i = rho & 15; return 8 * (i >> 2) + 4 * n + (i & 3); }

struct Unit { int pm, pn; };
struct Gemm { const bf16_t* A; const bf16_t* Bt; int M, N, K; };

struct StaticOrder {
    int nM, nN, nwg, G, c;
    __host__ __device__ void init(int M, int N, int G_, int c_) { nM = M / BM; nN = N / BM; nwg = nM * nN; G = G_; c = c_; }
    __host__ __device__ bool next(int i, Unit& u) const {
        const long L = (long)i * G + c; if (L >= nwg) return false;
        int wgid = (int)L; { const int q = nwg / NXCD, r = nwg % NXCD, xcd = wgid % NXCD, off = wgid / NXCD; wgid = (xcd < r ? xcd * (q + 1) : r * (q + 1) + (xcd - r) * q) + off; }
        const int nig = WGM * nN, gid = wgid / nig, fm = gid * WGM, gsz = (nM - fm) < WGM ? (nM - fm) : WGM;
        u.pm = fm + ((wgid % nig) % gsz); u.pn = (wgid % nig) / gsz; return true;
    }
    __device__ __forceinline__ void a_ready(const Unit&) const {}
    __device__ __forceinline__ void done(const Unit&) const {}
};

__device__ __forceinline__ unsigned cvt_pk_bf16(float lo, float hi) { unsigned r; asm volatile("v_cvt_pk_bf16_f32 %0, %1, %2" : "=v"(r) : "v"(lo), "v"(hi)); return r; }
typedef float f32x2 __attribute__((ext_vector_type(2)));

__device__ __forceinline__ float row_rstd(const float* ssq, int row) {
    const f32x4* p = (const f32x4*)(ssq + (size_t)row * 16);
    const f32x4 a = p[0], b = p[1], c = p[2], d = p[3];
    const f32x4 s = (a + b) + (c + d);
    const float t = (s[0] + s[1]) + (s[2] + s[3]);
    return 1.0f / sqrtf(t * (1.0f / 1024.0f) + 1e-6f);
}
template <int ACT> struct EpiScale {
    static constexpr bool PERM = true, AFTER_DRAIN = false;
    bf16_t* O; int ldc; const float* ssq;
    __device__ __forceinline__ void operator()(const f32x4 (&acc)[2][2][4][2], const Unit& u, int wr, int wc, int fr, int fq) const {
        const int row0 = u.pm * BM + wr * 64 + fr; const int col0 = u.pn * BM + wc * 32 + 8 * fq;
#pragma unroll
        for (int ai = 0; ai < 2; ++ai)
#pragma unroll
            for (int m = 0; m < 4; ++m) { const int row = row0 + ai * HALF + m * 16; const float rs = row_rstd(ssq, row); bf16_t* rowp = O + (size_t)row * ldc + col0;
#pragma unroll
                for (int bj = 0; bj < 2; ++bj) { f32x4 v0 = acc[ai][bj][m][0] * rs, v1 = acc[ai][bj][m][1] * rs;
                    if (ACT == 1) {
#pragma unroll
                        for (int e = 0; e < 4; ++e) { const float a = fmaxf(v0[e], 0.f), b = fmaxf(v1[e], 0.f); v0[e] = a * a; v1[e] = b * b; } }
                    u32x4 w; w.x = cvt_pk_bf16(v0[0], v0[1]); w.y = cvt_pk_bf16(v0[2], v0[3]); w.z = cvt_pk_bf16(v1[0], v1[1]); w.w = cvt_pk_bf16(v1[2], v1[3]);
                    *(u32x4*)(rowp + bj * HALF) = w; } }
    }
};
struct EpiResid {
    static constexpr bool PERM = true, AFTER_DRAIN = false;
    const float* base; float* out; bf16_t* xb; float* ssq;
    __device__ __forceinline__ void operator()(const f32x4 (&acc)[2][2][4][2], const Unit& u, int wr, int wc, int fr, int fq) const {
        const int row0 = u.pm * BM + wr * 64 + fr; const int col0 = u.pn * BM + wc * 32 + 8 * fq;
#pragma unroll
        for (int ai = 0; ai < 2; ++ai)
#pragma unroll
            for (int m = 0; m < 4; ++m) { const int row = row0 + ai * HALF + m * 16; const size_t off = (size_t)row * 1024 + col0; float s = 0.f;
#pragma unroll
                for (int bj = 0; bj < 2; ++bj) { const f32x4 b0 = *(const f32x4*)(base + off + bj * HALF), b1 = *(const f32x4*)(base + off + bj * HALF + 4);
                    const f32x4 v0 = b0 + acc[ai][bj][m][0], v1 = b1 + acc[ai][bj][m][1];
                    *(f32x4*)(out + off + bj * HALF) = v0; *(f32x4*)(out + off + bj * HALF + 4) = v1;
                    if (xb) { u32x4 w; w.x = cvt_pk_bf16(v0[0], v0[1]); w.y = cvt_pk_bf16(v0[2], v0[3]); w.z = cvt_pk_bf16(v1[0], v1[1]); w.w = cvt_pk_bf16(v1[2], v1[3]); *(u32x4*)(xb + off + bj * HALF) = w; }
                    s += (v0[0] * v0[0] + v0[1] * v0[1]) + (v0[2] * v0[2] + v0[3] * v0[3]) + (v1[0] * v1[0] + v1[1] * v1[1]) + (v1[2] * v1[2] + v1[3] * v1[3]); }
                s += __shfl_xor(s, 16); s += __shfl_xor(s, 32);
                if (fq == 0) ssq[(size_t)row * 16 + u.pn * 4 + wc] = s;
                asm volatile("" ::: "memory"); }
    }
};

template <class Epi, class Sched, bool ALIGN_EPI = false, bool SP2 = false>
__device__ __forceinline__ void gemm_phase(PG8_LAS unsigned char* lds, const Gemm g, const Sched& S, const Epi& E) {
    const int tid = threadIdx.x, wid = __builtin_amdgcn_readfirstlane(tid >> 6), lane = tid & 63, wr = wid >> 2, wc = wid & 3, fr = lane & 15, fq = lane >> 4;
    const int K = g.K, nt = K / BK;
    unsigned voffA[2], voffB[2];
#pragma unroll
    for (int i = 0; i < 2; ++i) { int R, C; stage_rc(tid * 16 + i * 8192, R, C); const int Rb = Epi::PERM ? ((R & ~31) + perm32(R & 31)) : R;
        voffA[i] = (unsigned)(R * K + C) * 2u; voffB[i] = (unsigned)(Rb * K + C) * 2u; }
    const size_t kstep = (size_t)(BK * 2);
    const size_t hstep = (size_t)HALF * K * 2;
    const size_t tstep = 2 * hstep;
    const unsigned ldsw = (unsigned)wid * 1024u;
    const int aoff = lds_byte(wr * 64 + fr, fq * 8), boff = lds_byte(wc * 32 + fr, fq * 8);
#define PG8_SA(b, h) (((b) * 2 + (h)) * HTB)
#define PG8_SB(b, h) ((4 + (b) * 2 + (h)) * HTB)
#define PG8_STAGE(bufoff, gbase, voff) do { _Pragma("unroll") for (int _i = 0; _i < 2; ++_i) \
        __builtin_amdgcn_global_load_lds((const unsigned*)((const char*)(gbase) + (voff)[_i]), (PG8_LAS unsigned*)(lds + (bufoff) + ldsw + _i * 8192), 16, 0, 0); } while (0)
#define PG8_LDA(dst, b, h) do { _Pragma("unroll") for (int m = 0; m < 4; ++m) _Pragma("unroll") for (int k = 0; k < 2; ++k) dst[m][k] = *(const PG8_LAS bf16x8*)(lds + PG8_SA(b, h) + aoff + m * 2048 + k * 1024); } while (0)
#define PG8_LDB(dst, b, h) do { _Pragma("unroll") for (int n = 0; n < 2; ++n) _Pragma("unroll") for (int k = 0; k < 2; ++k) dst[n][k] = *(const PG8_LAS bf16x8*)(lds + PG8_SB(b, h) + boff + n * 2048 + k * 1024); } while (0)
#define PG8_MMA(ai, bj, At, Bt) do { __builtin_amdgcn_s_setprio(1); _Pragma("unroll") for (int m = 0; m < 4; ++m) _Pragma("unroll") for (int n = 0; n < 2; ++n) _Pragma("unroll") for (int k = 0; k < 2; ++k) \
        acc[ai][bj][m][n] = __builtin_amdgcn_mfma_f32_16x16x32_bf16(Bt[n][k], At[m][k], acc[ai][bj][m][n], 0, 0, 0); __builtin_amdgcn_s_setprio(0); } while (0)
#define PG8_WAIT_V(n) asm volatile("s_waitcnt vmcnt(" #n ")" ::: "memory")
#define PG8_WAIT_L(n) asm volatile("s_waitcnt lgkmcnt(" #n ")" ::: "memory")
#define PG8_BAR __builtin_amdgcn_s_barrier()
#define PG8_SCHED __builtin_amdgcn_sched_barrier(0)
    Unit cur, nxt; int ui = 0;
    if (!S.next(0, cur)) return;
    f32x4 acc[2][2][4][2];
#pragma unroll
    for (int a = 0; a < 2; ++a)
#pragma unroll
        for (int b = 0; b < 2; ++b)
#pragma unroll
            for (int m = 0; m < 4; ++m)
#pragma unroll
                for (int n = 0; n < 2; ++n) acc[a][b][m][n] = (f32x4){0.f, 0.f, 0.f, 0.f};
    bf16x8 At[4][2], B0[2][2], B1[2][2];
    const char* cA = (const char*)g.A + (size_t)cur.pm * tstep; const char* cB = (const char*)g.Bt + (size_t)cur.pn * tstep;
    S.a_ready(cur);
    if constexpr (SP2) {
        PG8_STAGE(PG8_SB(0, 0), cB, voffB); PG8_STAGE(PG8_SB(0, 1), cB + hstep, voffB); PG8_STAGE(PG8_SA(0, 0), cA, voffA); PG8_STAGE(PG8_SA(0, 1), cA + hstep, voffA);
        if (wr == 1) PG8_BAR;
        PG8_WAIT_V(2); PG8_BAR;
        PG8_STAGE(PG8_SB(1, 0), cB + kstep, voffB); PG8_STAGE(PG8_SA(1, 0), cA + kstep, voffA); PG8_STAGE(PG8_SB(1, 1), cB + hstep + kstep, voffB);
        PG8_WAIT_V(6); PG8_BAR;
    } else {
        PG8_STAGE(PG8_SB(0, 0), cB, voffB); PG8_STAGE(PG8_SA(0, 0), cA, voffA); PG8_STAGE(PG8_SB(0, 1), cB + hstep, voffB); PG8_STAGE(PG8_SA(0, 1), cA + hstep, voffA);
        if (wr == 1) PG8_BAR;
        PG8_WAIT_V(4); PG8_BAR;
        PG8_STAGE(PG8_SB(1, 0), cB + kstep, voffB); PG8_STAGE(PG8_SA(1, 0), cA + kstep, voffA); PG8_STAGE(PG8_SB(1, 1), cB + hstep + kstep, voffB);
        PG8_WAIT_V(6); PG8_BAR;
    }
    for (;;) {
        const bool has_next = S.next(ui + 1, nxt);
        const char* nA = has_next ? (const char*)g.A + (size_t)nxt.pm * tstep : cA; const char* nB = has_next ? (const char*)g.Bt + (size_t)nxt.pn * tstep : cB;
        for (int t = 0; t < nt; t += 2) {
            const bool last = (t == nt - 2);
            const char* a1 = cA + (size_t)(t + 1) * kstep;
            const char* a2 = last ? nA : cA + (size_t)(t + 2) * kstep; const char* b2 = last ? nB : cB + (size_t)(t + 2) * kstep;
            const char* a3 = a2 + kstep; const char* b3 = b2 + kstep;
            if (last && has_next) S.a_ready(nxt);
            if constexpr (SP2) {
            PG8_LDB(B0, 0, 0); PG8_LDB(B1, 0, 1); PG8_SCHED; PG8_LDA(At, 0, 0); PG8_STAGE(PG8_SA(1, 1), a1 + hstep, voffA);
            PG8_WAIT_V(8); PG8_WAIT_L(0); PG8_BAR; PG8_MMA(0, 0, At, B0); PG8_MMA(0, 1, At, B1); PG8_BAR; PG8_SCHED;
            PG8_LDA(At, 0, 1); PG8_STAGE(PG8_SB(0, 0), b2, voffB); PG8_STAGE(PG8_SB(0, 1), b2 + hstep, voffB); PG8_STAGE(PG8_SA(0, 0), a2, voffA);
            PG8_WAIT_V(8); PG8_WAIT_L(0); PG8_BAR; PG8_MMA(1, 0, At, B0); PG8_MMA(1, 1, At, B1); PG8_BAR; PG8_SCHED;
            PG8_LDB(B0, 1, 0); PG8_LDB(B1, 1, 1); PG8_SCHED; PG8_LDA(At, 1, 0); PG8_STAGE(PG8_SA(0, 1), a2 + hstep, voffA);
            PG8_WAIT_V(8); PG8_WAIT_L(0); PG8_BAR; PG8_MMA(0, 0, At, B0); PG8_MMA(0, 1, At, B1); PG8_BAR; PG8_SCHED;
            PG8_LDA(At, 1, 1); PG8_STAGE(PG8_SB(1, 0), b3, voffB); PG8_STAGE(PG8_SB(1, 1), b3 + hstep, voffB); PG8_STAGE(PG8_SA(1, 0), a3, voffA);
            PG8_WAIT_V(8); PG8_WAIT_L(0); PG8_BAR; PG8_MMA(1, 0, At, B0); PG8_MMA(1, 1, At, B1); PG8_BAR; PG8_SCHED;
            } else {
            PG8_LDB(B0, 0, 0); PG8_SCHED; PG8_LDA(At, 0, 0); PG8_STAGE(PG8_SA(1, 1), a1 + hstep, voffA);
            PG8_WAIT_L(8); PG8_BAR; PG8_WAIT_L(0); PG8_MMA(0, 0, At, B0); PG8_BAR; PG8_SCHED;
            PG8_LDB(B1, 0, 1); PG8_STAGE(PG8_SB(0, 0), b2, voffB);
            PG8_BAR; PG8_WAIT_L(0); PG8_MMA(0, 1, At, B1); PG8_BAR;
            PG8_LDA(At, 0, 1); PG8_STAGE(PG8_SA(0, 0), a2, voffA);
            PG8_BAR; PG8_WAIT_L(0); PG8_MMA(1, 0, At, B0); PG8_BAR; PG8_SCHED;
            PG8_STAGE(PG8_SB(0, 1), b2 + hstep, voffB);
            PG8_WAIT_V(6); PG8_BAR; PG8_MMA(1, 1, At, B1); PG8_BAR;
            PG8_LDB(B0, 1, 0); PG8_SCHED; PG8_LDA(At, 1, 0); PG8_STAGE(PG8_SA(0, 1), a2 + hstep, voffA);
            PG8_WAIT_L(8); PG8_BAR; PG8_WAIT_L(0); PG8_MMA(0, 0, At, B0); PG8_BAR; PG8_SCHED;
            PG8_LDB(B1, 1, 1); PG8_STAGE(PG8_SB(1, 0), b3, voffB);
            PG8_BAR; PG8_WAIT_L(0); PG8_MMA(0, 1, At, B1); PG8_BAR;
            PG8_LDA(At, 1, 1); PG8_STAGE(PG8_SA(1, 0), a3, voffA);
            PG8_BAR; PG8_WAIT_L(0); PG8_MMA(1, 0, At, B0); PG8_BAR; PG8_SCHED;
            PG8_STAGE(PG8_SB(1, 1), b3 + hstep, voffB);
            PG8_WAIT_V(6); PG8_BAR; PG8_MMA(1, 1, At, B1); PG8_BAR;
            }
        }
        if constexpr (ALIGN_EPI) { if (wr == 0) PG8_BAR; }
        if constexpr (!Epi::AFTER_DRAIN) { E(acc, cur, wr, wc, fr, fq); S.done(cur); }
        if (!has_next) break;
#pragma unroll
        for (int a = 0; a < 2; ++a)
#pragma unroll
            for (int b = 0; b < 2; ++b)
#pragma unroll
                for (int m = 0; m < 4; ++m)
#pragma unroll
                    for (int n = 0; n < 2; ++n) acc[a][b][m][n] = (f32x4){0.f, 0.f, 0.f, 0.f};
        cur = nxt; cA = nA; cB = nB; ++ui;
        if constexpr (ALIGN_EPI) { if (wr == 1) PG8_BAR; }
    }
    PG8_WAIT_V(0);
    if constexpr (!ALIGN_EPI) { if (wr == 0) PG8_BAR; }
    PG8_BAR;
    if constexpr (Epi::AFTER_DRAIN) { E.fused(acc, cur, wr, wc, fr, fq, lds, wid, lane); S.done(cur); }
#undef PG8_SA
#undef PG8_SB
#undef PG8_STAGE
#undef PG8_LDA
#undef PG8_LDB
#undef PG8_MMA
#undef PG8_WAIT_V
#undef PG8_WAIT_L
#undef PG8_BAR
#undef PG8_SCHED
}
}

#include <hip/hip_cooperative_groups.h>
namespace cg = cooperative_groups;

#define LAS __attribute__((address_space(3)))
typedef unsigned short bf16;
typedef unsigned v4u __attribute__((ext_vector_type(4)));
typedef unsigned v2u __attribute__((ext_vector_type(2)));
typedef float f32x4 __attribute__((ext_vector_type(4)));
typedef short bf16x8 __attribute__((ext_vector_type(8)));
typedef short s16x4 __attribute__((ext_vector_type(4)));

constexpr int NWAVES = 8, NT = NWAVES * 64;
constexpr int BATCH = 4, SEQ = 4096, D = 1024, M = BATCH * SEQ, FF = 4096, NH = 16, HD = 64, GW = 64, ROWS = 64, KH = 8, WW = 16;
constexpr size_t MiB = 1u << 20;
constexpr size_t WS_SSQ = 1 * MiB;
constexpr size_t WS_WIN = 4 * MiB, WS_WOUT = 10 * MiB, WS_WQKV = 12 * MiB, WS_WO = 18 * MiB, WS_WUP0 = 20 * MiB, WS_WUP1 = 28 * MiB, WS_WDN0 = 36 * MiB, WS_WDN1 = 44 * MiB;
constexpr size_t WS_XB = 52 * MiB;
constexpr size_t WS_U = 84 * MiB;
constexpr size_t WS_Y = 180 * MiB;
constexpr size_t WS_A = 84 * MiB;
constexpr size_t WS_END = 212 * MiB;
constexpr int LDS_BYTES = 151552;

__device__ __forceinline__ unsigned f2bf(float f) { unsigned u = __builtin_bit_cast(unsigned, f); return (u + 0x7fffu + ((u >> 16) & 1u)) >> 16; }
__device__ __forceinline__ unsigned pk2(float lo, float hi) { return f2bf(lo) | (f2bf(hi) << 16); }
__device__ __forceinline__ float bf_lo(unsigned w) { return __builtin_bit_cast(float, w << 16); }
__device__ __forceinline__ float bf_hi(unsigned w) { return __builtin_bit_cast(float, w & 0xffff0000u); }
#define LDS_WAIT() asm volatile("s_waitcnt lgkmcnt(0)" ::: "memory")

__device__ __forceinline__ float wave_sum(float v) {
#pragma unroll
    for (int o = 1; o < 64; o <<= 1) v += __shfl_xor(v, o);
    return v;
}

__device__ __forceinline__ void p0_transpose_item(const float* W, int K, int N, bf16* WT, const float* g, LAS float* scr, int item, int lane) {
    const int nblk = N / 32, kb = item / nblk, nb = item % nblk, k0 = 64 * kb, n0 = 32 * nb;
#pragma unroll 8
    for (int i = 0; i < 32; ++i) { const int kk = 2 * i + (lane >> 5); float w = W[(size_t)(k0 + kk) * N + n0 + (lane & 31)]; if (g) w *= g[k0 + kk]; scr[kk * 33 + (lane & 31)] = w; }
    LDS_WAIT(); asm volatile("" ::: "memory");
    const int c = lane & 7;
#pragma unroll
    for (int j = 0; j < 4; ++j) { const int n = (lane >> 3) + 8 * j; const LAS float* s = scr + (8 * c) * 33 + n;
        v4u o; o.x = pk2(s[0 * 33], s[1 * 33]); o.y = pk2(s[2 * 33], s[3 * 33]); o.z = pk2(s[4 * 33], s[5 * 33]); o.w = pk2(s[6 * 33], s[7 * 33]);
        *(v4u*)(WT + (size_t)(n0 + n) * K + k0 + 8 * c) = o; }
    LDS_WAIT(); asm volatile("" ::: "memory");
}

struct Args {
    const float* x; const float* norm_mix; const float* conv_w_in; const float* conv_w; const float* conv_w_out; const float* attn_w_qkv; const float* attn_rpb; const float* attn_w_o;
    const float* norm_mlp; const float* mlp_w_up; const float* mlp_w_down; const float* norm_final; float* out; unsigned char* ws;
};

__device__ __forceinline__ void p0_prologue(const Args& a, LAS unsigned char* lds, int gw, int NGW, int wave, int lane) {
    LAS float* scr = (LAS float*)(lds + wave * 16384);
    unsigned char* ws = a.ws;
    constexpr int I_IN = 16 * 96, I_SQ = 16 * 32, I_UP = 16 * 128, I_DN = 64 * 32;
    constexpr int NITEMS = 2 * I_IN + 2 * I_SQ + 2 * I_UP + 2 * I_DN;
    for (int it = gw; it < NITEMS; it += NGW) {
        int r = it;
        if (r < I_IN) { p0_transpose_item(a.conv_w_in, D, 3 * D, (bf16*)(ws + WS_WIN), a.norm_mix, scr, r, lane); continue; } r -= I_IN;
        if (r < I_IN) { p0_transpose_item(a.attn_w_qkv, D, 3 * D, (bf16*)(ws + WS_WQKV), a.norm_mix + D, scr, r, lane); continue; } r -= I_IN;
        if (r < I_SQ) { p0_transpose_item(a.conv_w_out, D, D, (bf16*)(ws + WS_WOUT), nullptr, scr, r, lane); continue; } r -= I_SQ;
        if (r < I_SQ) { p0_transpose_item(a.attn_w_o, D, D, (bf16*)(ws + WS_WO), nullptr, scr, r, lane); continue; } r -= I_SQ;
        if (r < I_UP) { p0_transpose_item(a.mlp_w_up, D, FF, (bf16*)(ws + WS_WUP0), a.norm_mlp, scr, r, lane); continue; } r -= I_UP;
        if (r < I_UP) { p0_transpose_item(a.mlp_w_up + (size_t)D * FF, D, FF, (bf16*)(ws + WS_WUP1), a.norm_mlp + D, scr, r, lane); continue; } r -= I_UP;
        if (r < I_DN) { p0_transpose_item(a.mlp_w_down, FF, D, (bf16*)(ws + WS_WDN0), nullptr, scr, r, lane); continue; } r -= I_DN;
        p0_transpose_item(a.mlp_w_down + (size_t)FF * D, FF, D, (bf16*)(ws + WS_WDN1), nullptr, scr, r, lane);
    }
    bf16* XB = (bf16*)(ws + WS_XB); float* SSQ = (float*)(ws + WS_SSQ);
    for (int m = gw; m < M; m += NGW) {
        const f32x4* xr = (const f32x4*)(a.x + (size_t)m * D) + lane; f32x4 v[4]; float s = 0.f;
#pragma unroll
        for (int j = 0; j < 4; ++j) { v[j] = xr[64 * j]; s += (v[j].x * v[j].x + v[j].y * v[j].y) + (v[j].z * v[j].z + v[j].w * v[j].w); }
        s = wave_sum(s);
        v2u* o8 = (v2u*)(XB + (size_t)m * D) + lane;
#pragma unroll
        for (int j = 0; j < 4; ++j) { v2u o; o.x = pk2(v[j].x, v[j].y); o.y = pk2(v[j].z, v[j].w); o8[64 * j] = o; }
        if (lane < 16) SSQ[(size_t)m * 16 + lane] = (lane == 0) ? s : 0.f;
    }
}

__device__ __forceinline__ void conv_phase(const Args& a, int gw, int NGW, int lane) {
    const bf16* U = (const bf16*)(a.ws + WS_U); bf16* Y = (bf16*)(a.ws + WS_Y);
    constexpr int TCH = 16, NTASK = (M / TCH) * 2;
    for (int task = gw; task < NTASK; task += NGW) {
        const int ch = task >> 1, hf = task & 1, t0 = ch * TCH, d0 = hf * 512 + lane * 8;
        float w0[8], w1[8], w2[8];
#pragma unroll
        for (int e = 0; e < 8; ++e) { w0[e] = a.conv_w[d0 + e]; w1[e] = a.conv_w[D + d0 + e]; w2[e] = a.conv_w[2 * D + d0 + e]; }
        float zp[8], zc[8], zn[8];
        auto loadz = [&](int t, float* z) {
            const v4u c = *(const v4u*)(U + (size_t)t * (3 * D) + D + d0), v = *(const v4u*)(U + (size_t)t * (3 * D) + 2 * D + d0);
            z[0] = bf_lo(c.x) * bf_lo(v.x); z[1] = bf_hi(c.x) * bf_hi(v.x); z[2] = bf_lo(c.y) * bf_lo(v.y); z[3] = bf_hi(c.y) * bf_hi(v.y);
            z[4] = bf_lo(c.z) * bf_lo(v.z); z[5] = bf_hi(c.z) * bf_hi(v.z); z[6] = bf_lo(c.w) * bf_lo(v.w); z[7] = bf_hi(c.w) * bf_hi(v.w); };
        if ((t0 & (SEQ - 1)) == 0) {
#pragma unroll
            for (int e = 0; e < 8; ++e) zp[e] = 0.f; } else loadz(t0 - 1, zp);
        loadz(t0, zc);
        for (int i = 0; i < TCH; ++i) {
            const int t = t0 + i;
            if (((t + 1) & (SEQ - 1)) == 0) {
#pragma unroll
                for (int e = 0; e < 8; ++e) zn[e] = 0.f; } else loadz(t + 1, zn);
            const v4u bb = *(const v4u*)(U + (size_t)t * (3 * D) + d0);
            float bv[8] = {bf_lo(bb.x), bf_hi(bb.x), bf_lo(bb.y), bf_hi(bb.y), bf_lo(bb.z), bf_hi(bb.z), bf_lo(bb.w), bf_hi(bb.w)};
            float y[8];
#pragma unroll
            for (int e = 0; e < 8; ++e) y[e] = bv[e] * (w0[e] * zp[e] + w1[e] * zc[e] + w2[e] * zn[e]);
            v4u o; o.x = pk2(y[0], y[1]); o.y = pk2(y[2], y[3]); o.z = pk2(y[4], y[5]); o.w = pk2(y[6], y[7]);
            *(v4u*)(Y + (size_t)t * D + d0) = o;
#pragma unroll
            for (int e = 0; e < 8; ++e) { zp[e] = zc[e]; zc[e] = zn[e]; }
        }
    }
}

__device__ __forceinline__ int swz(int col) { return ((col >> 1) & 1) | (((col >> 3) & 3) << 1); }
__device__ __forceinline__ void attn_load_row(const bf16* QKV, LAS unsigned char* Kl, LAS unsigned char* Vl, int b, int h, int row, int tid) {
    const int col = tid >> 3, chunk = tid & 7; const size_t tok = (size_t)b * SEQ + row * GW + col;
    const v4u k = *(const v4u*)(QKV + tok * (3 * D) + D + h * HD + chunk * 8), v = *(const v4u*)(QKV + tok * (3 * D) + 2 * D + h * HD + chunk * 8);
    const int off = (((row & 7) * 64 + col) << 7) + ((chunk ^ swz(col)) << 4);
    *(LAS v4u*)(Kl + off) = k; *(LAS v4u*)(Vl + off) = v;
}
__device__ __forceinline__ void attn_phase(const Args& a, LAS unsigned char* lds, int G, int bid, int tid) {
    const bf16* QKV = (const bf16*)(a.ws + WS_U); bf16* Y = (bf16*)(a.ws + WS_Y);
    LAS unsigned char* Kl = lds; LAS unsigned char* Vl = lds + 65536; LAS float* Bl = (LAS float*)(lds + 131072);
    const int wave = __builtin_amdgcn_readfirstlane(tid >> 6), lane = tid & 63, g = lane >> 4, qi = lane & 15;
    for (int st = bid; st < BATCH * NH * 4; st += G) {
        const int b = st >> 6, h = (st >> 2) & 15, seg = st & 3, r0 = seg * 16;
        __syncthreads();
        for (int i = tid; i < 15 * 31; i += NT) Bl[i] = a.attn_rpb[h * 465 + i];
        int s_prev = min(max(r0 - 4, 0), ROWS - KH);
        for (int i = 0; i < 8; ++i) attn_load_row(QKV, Kl, Vl, b, h, s_prev + i, tid);
        __syncthreads();
        for (int r = r0; r < r0 + 16; ++r) {
            const int s = min(max(r - 4, 0), ROWS - KH);
            if (s != s_prev) { attn_load_row(QKV, Kl, Vl, b, h, s + 7, tid); s_prev = s; __syncthreads(); }
            if (wave < 4) {
                const int j = wave, c0 = (j == 0) ? 0 : (j == 1) ? 8 : (j == 2) ? 24 : 32;
                const int c = 16 * j + qi, cs = min(max(c - 8, 0), GW - WW);
                const size_t qtok = (size_t)b * SEQ + r * GW + c;
                const bf16x8 q0 = *(const bf16x8*)(QKV + qtok * (3 * D) + h * HD + g * 8), q1 = *(const bf16x8*)(QKV + qtok * (3 * D) + h * HD + 32 + g * 8);
                f32x4 sc[8][2];
                const int kcolA = c0 + 8 * (qi >> 2) + (qi & 3);
                float mx = -INFINITY;
#pragma unroll
                for (int i = 0; i < 8; ++i) {
                    const int slot = (s + i) & 7;
#pragma unroll
                    for (int T = 0; T < 2; ++T) {
                        const int kc = kcolA + 4 * T; const int base = ((slot * 64 + kc) << 7), sw = swz(kc);
                        const bf16x8 k0 = *(const LAS bf16x8*)(Kl + base + ((g ^ sw) << 4)), k1 = *(const LAS bf16x8*)(Kl + base + (((4 + g) ^ sw) << 4));
                        f32x4 acc = (f32x4){0.f, 0.f, 0.f, 0.f};
                        acc = __builtin_amdgcn_mfma_f32_16x16x32_bf16(k0, q0, acc, 0, 0, 0);
                        acc = __builtin_amdgcn_mfma_f32_16x16x32_bf16(k1, q1, acc, 0, 0, 0);
                        const int roff = (s + i - r + 7) * 31;
#pragma unroll
                        for (int e = 0; e < 4; ++e) {
                            const int kcol = c0 + 8 * g + 4 * T + e; const bool ok = (kcol >= cs) && (kcol < cs + WW);
                            const float bias = Bl[ok ? roff + (kcol - c + 15) : 0];
                            const float v = ok ? acc[e] * 0.125f + bias : -INFINITY;
                            acc[e] = v; mx = fmaxf(mx, v); }
                        sc[i][T] = acc;
                    }
                }
                mx = fmaxf(mx, __shfl_xor(mx, 16)); mx = fmaxf(mx, __shfl_xor(mx, 32));
                float sum = 0.f;
#pragma unroll
                for (int i = 0; i < 8; ++i)
#pragma unroll
                    for (int T = 0; T < 2; ++T)
#pragma unroll
                        for (int e = 0; e < 4; ++e) { const float p = __builtin_amdgcn_exp2f((sc[i][T][e] - mx) * 1.4426950408889634f); sc[i][T][e] = p; sum += p; }
                sum += __shfl_xor(sum, 16); sum += __shfl_xor(sum, 32);
                f32x4 o[4];
#pragma unroll
                for (int dt = 0; dt < 4; ++dt) o[dt] = (f32x4){0.f, 0.f, 0.f, 0.f};
                const int vq = qi >> 2, vp = qi & 3, vcol = c0 + 8 * g + vq, vsw = swz(vcol);
#pragma unroll
                for (int i = 0; i < 8; ++i) {
                    const int slot = (s + i) & 7;
                    v4u pw; pw.x = pg8::cvt_pk_bf16(sc[i][0][0], sc[i][0][1]); pw.y = pg8::cvt_pk_bf16(sc[i][0][2], sc[i][0][3]); pw.z = pg8::cvt_pk_bf16(sc[i][1][0], sc[i][1][1]); pw.w = pg8::cvt_pk_bf16(sc[i][1][2], sc[i][1][3]);
                    const bf16x8 pf = __builtin_bit_cast(bf16x8, pw);
                    const int vbase = ((slot * 64 + vcol) << 7) + (vp & 1) * 8;
#pragma unroll
                    for (int dt = 0; dt < 4; ++dt) {
                        const int ch = ((dt * 2 + (vp >> 1)) ^ vsw) << 4;
                        const s16x4 lo = __builtin_bit_cast(s16x4, __builtin_amdgcn_ds_read_tr16_b64_v4i16((LAS s16x4*)(Vl + vbase + ch)));
                        const s16x4 hi = __builtin_bit_cast(s16x4, __builtin_amdgcn_ds_read_tr16_b64_v4i16((LAS s16x4*)(Vl + vbase + ch + 512)));
                        bf16x8 vf; vf[0] = lo[0]; vf[1] = lo[1]; vf[2] = lo[2]; vf[3] = lo[3]; vf[4] = hi[0]; vf[5] = hi[1]; vf[6] = hi[2]; vf[7] = hi[3];
                        o[dt] = __builtin_amdgcn_mfma_f32_16x16x32_bf16(vf, pf, o[dt], 0, 0, 0);
                    }
                }
                const float inv = 1.0f / sum;
                bf16* yp = Y + qtok * D + h * HD + 4 * g;
#pragma unroll
                for (int dt = 0; dt < 4; ++dt) { v2u w; w.x = pg8::cvt_pk_bf16(o[dt][0] * inv, o[dt][1] * inv); w.y = pg8::cvt_pk_bf16(o[dt][2] * inv, o[dt][3] * inv); *(v2u*)(yp + dt * 16) = w; }
            }
            __syncthreads();
        }
    }
}

__device__ __forceinline__ void final_norm(const Args& a, int gw, int NGW, int lane) {
    const float* SSQ = (const float*)(a.ws + WS_SSQ);
    f32x4 gv[4];
#pragma unroll
    for (int j = 0; j < 4; ++j) gv[j] = ((const f32x4*)a.norm_final)[lane + 64 * j];
    for (int m = gw; m < M; m += NGW) {
        const float rs = pg8::row_rstd(SSQ, m);
        f32x4* xr = (f32x4*)(a.out + (size_t)m * D) + lane;
#pragma unroll
        for (int j = 0; j < 4; ++j) { f32x4 v = xr[64 * j]; v = v * rs * gv[j]; xr[64 * j] = v; }
    }
}

__global__ void __launch_bounds__(NT) fwd_megakernel(Args a) {
    extern __shared__ __attribute__((aligned(16))) unsigned char lds_raw[];
    LAS unsigned char* lds = (LAS unsigned char*)lds_raw;
    cg::grid_group grid = cg::this_grid();
    const int tid = threadIdx.x, lane = tid & 63, wave = __builtin_amdgcn_readfirstlane(tid >> 6);
    const int G = gridDim.x, bid = blockIdx.x, gw = bid * NWAVES + wave, NGW = G * NWAVES;
    unsigned char* ws = a.ws;
    bf16* XB = (bf16*)(ws + WS_XB); bf16* U = (bf16*)(ws + WS_U); bf16* Y = (bf16*)(ws + WS_Y); bf16* A = (bf16*)(ws + WS_A); float* SSQ = (float*)(ws + WS_SSQ);

    p0_prologue(a, lds, gw, NGW, wave, lane);
    grid.sync();
    { pg8::Gemm g{XB, (const bf16*)(ws + WS_WIN), M, 3 * D, D}; pg8::StaticOrder S; S.init(M, 3 * D, G, bid); pg8::EpiScale<0> E{U, 3 * D, SSQ};
      pg8::gemm_phase<pg8::EpiScale<0>, pg8::StaticOrder, true, true>(lds, g, S, E); }
    grid.sync();
    conv_phase(a, gw, NGW, lane);
    grid.sync();
    { pg8::Gemm g{Y, (const bf16*)(ws + WS_WOUT), M, D, D}; pg8::StaticOrder S; S.init(M, D, G, bid); pg8::EpiResid E{a.x, a.out, XB, SSQ};
      pg8::gemm_phase<pg8::EpiResid, pg8::StaticOrder, true, true>(lds, g, S, E); }
    grid.sync();
    { pg8::Gemm g{XB, (const bf16*)(ws + WS_WUP0), M, FF, D}; pg8::StaticOrder S; S.init(M, FF, G, bid); pg8::EpiScale<1> E{A, FF, SSQ};
      pg8::gemm_phase<pg8::EpiScale<1>, pg8::StaticOrder, true, true>(lds, g, S, E); }
    grid.sync();
    { pg8::Gemm g{A, (const bf16*)(ws + WS_WDN0), M, D, FF}; pg8::StaticOrder S; S.init(M, D, G, bid); pg8::EpiResid E{a.out, a.out, XB, SSQ};
      pg8::gemm_phase<pg8::EpiResid, pg8::StaticOrder, true, true>(lds, g, S, E); }
    grid.sync();
    { pg8::Gemm g{XB, (const bf16*)(ws + WS_WQKV), M, 3 * D, D}; pg8::StaticOrder S; S.init(M, 3 * D, G, bid); pg8::EpiScale<0> E{U, 3 * D, SSQ};
      pg8::gemm_phase<pg8::EpiScale<0>, pg8::StaticOrder, true, true>(lds, g, S, E); }
    grid.sync();
    attn_phase(a, lds, G, bid, tid);
    grid.sync();
    { pg8::Gemm g{Y, (const bf16*)(ws + WS_WO), M, D, D}; pg8::StaticOrder S; S.init(M, D, G, bid); pg8::EpiResid E{a.out, a.out, XB, SSQ};
      pg8::gemm_phase<pg8::EpiResid, pg8::StaticOrder, true, true>(lds, g, S, E); }
    grid.sync();
    { pg8::Gemm g{XB, (const bf16*)(ws + WS_WUP1), M, FF, D}; pg8::StaticOrder S; S.init(M, FF, G, bid); pg8::EpiScale<1> E{A, FF, SSQ};
      pg8::gemm_phase<pg8::EpiScale<1>, pg8::StaticOrder, true, true>(lds, g, S, E); }
    grid.sync();
    { pg8::Gemm g{A, (const bf16*)(ws + WS_WDN1), M, D, FF}; pg8::StaticOrder S; S.init(M, D, G, bid); pg8::EpiResid E{a.out, a.out, nullptr, SSQ};
      pg8::gemm_phase<pg8::EpiResid, pg8::StaticOrder, true, true>(lds, g, S, E); }
    grid.sync();
    final_norm(a, gw, NGW, lane);
}

extern "C" void kernel_launch(void* const* d_in, const int* in_sizes, int n_in, void* d_out, int out_size, void* d_ws, size_t ws_size, hipStream_t stream) {
    static int grid = 0;
    if (grid == 0) {
        if (n_in != 12 || in_sizes[0] != M * D || out_size != M * D || ws_size < WS_END) { fprintf(stderr, "kernel_launch: unexpected shapes (n_in %d, in0 %d, out %d, ws %zu)\n", n_in, n_in > 0 ? in_sizes[0] : -1, out_size, ws_size); grid = -1; return; }
        int dev = 0, cus = 0, per_cu = 0;
        (void)hipGetDevice(&dev); (void)hipDeviceGetAttribute(&cus, hipDeviceAttributeMultiprocessorCount, dev);
        (void)hipFuncSetAttribute((const void*)fwd_megakernel, hipFuncAttributeMaxDynamicSharedMemorySize, LDS_BYTES);
        (void)hipOccupancyMaxActiveBlocksPerMultiprocessor(&per_cu, (const void*)fwd_megakernel, NT, LDS_BYTES);
        if (per_cu < 1) { fprintf(stderr, "kernel_launch: occupancy query says %d blocks per CU\n", per_cu); per_cu = 1; }
        (void)hipGetLastError();
        grid = cus * per_cu;
    }
    if (grid < 0) return;
    Args a{};
    a.x = (const float*)d_in[0]; a.norm_mix = (const float*)d_in[1]; a.conv_w_in = (const float*)d_in[2]; a.conv_w = (const float*)d_in[3]; a.conv_w_out = (const float*)d_in[4];
    a.attn_w_qkv = (const float*)d_in[5]; a.attn_rpb = (const float*)d_in[6]; a.attn_w_o = (const float*)d_in[7]; a.norm_mlp = (const float*)d_in[8]; a.mlp_w_up = (const float*)d_in[9];
    a.mlp_w_down = (const float*)d_in[10]; a.norm_final = (const float*)d_in[11]; a.out = (float*)d_out; a.ws = (unsigned char*)d_ws;
    void* args[] = {&a};
    hipError_t e = hipLaunchCooperativeKernel((const void*)fwd_megakernel, dim3(grid), dim3(NT), args, LDS_BYTES, stream);
    if (e != hipSuccess) fprintf(stderr, "kernel_launch: cooperative launch failed: %s (grid %d)\n", hipGetErrorString(e), grid);
}
```

```cpp
#include <hip/hip_runtime.h>
#include <cstdio>
#include <cstdint>
namespace pg8 {
#define PG8_LAS __attribute__((address_space(3)))
typedef unsigned short bf16_t;
typedef short bf16x8 __attribute__((ext_vector_type(8)));
typedef float f32x4 __attribute__((ext_vector_type(4)));
typedef unsigned u32x4 __attribute__((ext_vector_type(4)));
constexpr int BM = 256, BK = 64, HALF = 128, HTB = HALF * BK * 2  , STAGE_BYTES = 8 * HTB, NXCD = 8, WGM = 8;

__host__ __device__ __forceinline__ int lds_byte(int r, int c) { const int st = (r >> 4) * 2 + (c >> 5), rr = r & 15, cc = c & 31, ob = rr * 64 + cc * 2; return st * 1024 + (ob ^ (((ob >> 9) & 1) << 5)); }
__host__ __device__ __forceinline__ void stage_rc(int b, int& R, int& C) { const int st = b / 1024, sb = b % 1024, swz = sb ^ (((sb >> 9) & 1) << 5); R = (st >> 1) * 16 + swz / 64; C = (st & 1) * 32 + (swz % 64) / 2; }
__host__ __device__ __forceinline__ int perm32(int rho) { const int n = rho >> 4, i = rho & 15; return 8 * (i >> 2) + 4 * n + (i & 3); }

struct Unit { int pm, pn; };
struct Gemm { const bf16_t* A; const bf16_t* Bt; int M, N, K; };

struct StaticOrder {
    int nM, nN, nwg, G, c;
    __host__ __device__ void init(int M, int N, int G_, int c_) { nM = M / BM; nN = N / BM; nwg = nM * nN; G = G_; c = c_; }
    __host__ __device__ bool next(int i, Unit& u) const {
        const long L = (long)i * G + c; if (L >= nwg) return false;
        int wgid = (int)L; { const int q = nwg / NXCD, r = nwg % NXCD, xcd = wgid % NXCD, off = wgid / NXCD; wgid = (xcd < r ? xcd * (q + 1) : r * (q + 1) + (xcd - r) * q) + off; }
        const int nig = WGM * nN, gid = wgid / nig, fm = gid * WGM, gsz = (nM - fm) < WGM ? (nM - fm) : WGM;
        u.pm = fm + ((wgid % nig) % gsz); u.pn = (wgid % nig) / gsz; return true;
    }
    __device__ __forceinline__ void a_ready(const Unit&) const {}
    __device__ __forceinline__ void done(const Unit&) const {}
};

__device__ __forceinline__ unsigned cvt_pk_bf16(float lo, float hi) { unsigned r; asm volatile("v_cvt_pk_bf16_f32 %0, %1, %2" : "=v"(r) : "v"(lo), "v"(hi)); return r; }
typedef float f32x2 __attribute__((ext_vector_type(2)));

__device__ __forceinline__ float row_rstd(const float* ssq, int row) {
    const f32x4* p = (const f32x4*)(ssq + (size_t)row * 16);
    const f32x4 a = p[0], b = p[1], c = p[2], d = p[3];
    const f32x4 s = (a + b) + (c + d);
    const float t = (s[0] + s[1]) + (s[2] + s[3]);
    return 1.0f / sqrtf(t * (1.0f / 1024.0f) + 1e-6f);
}
template <int ACT> struct EpiScale {
    static constexpr bool PERM = true, AFTER_DRAIN = false;
    bf16_t* O; int ldc; const float* ssq;
    __device__ __forceinline__ void operator()(const f32x4 (&acc)[2][2][4][2], const Unit& u, int wr, int wc, int fr, int fq) const {
        const int row0 = u.pm * BM + wr * 64 + fr; const int col0 = u.pn * BM + wc * 32 + 8 * fq;
#pragma unroll
        for (int ai = 0; ai < 2; ++ai)
#pragma unroll
            for (int m = 0; m < 4; ++m) { const int row = row0 + ai * HALF + m * 16; const float rs = row_rstd(ssq, row); bf16_t* rowp = O + (size_t)row * ldc + col0;
#pragma unroll
                for (int bj = 0; bj < 2; ++bj) { f32x4 v0 = acc[ai][bj][m][0] * rs, v1 = acc[ai][bj][m][1] * rs;
                    if (ACT == 1) {
#pragma unroll
                        for (int e = 0; e < 4; ++e) { const float a = fmaxf(v0[e], 0.f), b = fmaxf(v1[e], 0.f); v0[e] = a * a; v1[e] = b * b; } }
                    u32x4 w; w.x = cvt_pk_bf16(v0[0], v0[1]); w.y = cvt_pk_bf16(v0[2], v0[3]); w.z = cvt_pk_bf16(v1[0], v1[1]); w.w = cvt_pk_bf16(v1[2], v1[3]);
                    *(u32x4*)(rowp + bj * HALF) = w; } }
    }
};
struct EpiResid {
    static constexpr bool PERM = true, AFTER_DRAIN = false;
    const float* base; float* out; bf16_t* xb; float* ssq;
    __device__ __forceinline__ void operator()(const f32x4 (&acc)[2][2][4][2], const Unit& u, int wr, int wc, int fr, int fq) const {
        const int row0 = u.pm * BM + wr * 64 + fr; const int col0 = u.pn * BM + wc * 32 + 8 * fq;
#pragma unroll
        for (int ai = 0; ai < 2; ++ai)
#pragma unroll
            for (int m = 0; m < 4; ++m) { const int row = row0 + ai * HALF + m * 16; const size_t off = (size_t)row * 1024 + col0; float s = 0.f;
#pragma unroll
                for (int bj = 0; bj < 2; ++bj) { const f32x4 b0 = *(const f32x4*)(base + off + bj * HALF), b1 = *(const f32x4*)(base + off + bj * HALF + 4);
                    const f32x4 v0 = b0 + acc[ai][bj][m][0], v1 = b1 + acc[ai][bj][m][1];
                    *(f32x4*)(out + off + bj * HALF) = v0; *(f32x4*)(out + off + bj * HALF + 4) = v1;
                    if (xb) { u32x4 w; w.x = cvt_pk_bf16(v0[0], v0[1]); w.y = cvt_pk_bf16(v0[2], v0[3]); w.z = cvt_pk_bf16(v1[0], v1[1]); w.w = cvt_pk_bf16(v1[2], v1[3]); *(u32x4*)(xb + off + bj * HALF) = w; }
                    s += (v0[0] * v0[0] + v0[1] * v0[1]) + (v0[2] * v0[2] + v0[3] * v0[3]) + (v1[0] * v1[0] + v1[1] * v1[1]) + (v1[2] * v1[2] + v1[3] * v1[3]); }
                s += __shfl_xor(s, 16); s += __shfl_xor(s, 32);
                if (fq == 0) ssq[(size_t)row * 16 + u.pn * 4 + wc] = s;
                asm volatile("" ::: "memory"); }
    }
};

template <class Epi, class Sched, bool ALIGN_EPI = false, bool SP2 = false>
__device__ __forceinline__ void gemm_phase(PG8_LAS unsigned char* lds, const Gemm g, const Sched& S, const Epi& E) {
    const int tid = threadIdx.x, wid = __builtin_amdgcn_readfirstlane(tid >> 6), lane = tid & 63, wr = wid >> 2, wc = wid & 3, fr = lane & 15, fq = lane >> 4;
    const int K = g.K, nt = K / BK;
    unsigned voffA[2], voffB[2];
#pragma unroll
    for (int i = 0; i < 2; ++i) { int R, C; stage_rc(tid * 16 + i * 8192, R, C); const int Rb = Epi::PERM ? ((R & ~31) + perm32(R & 31)) : R;
        voffA[i] = (unsigned)(R * K + C) * 2u; voffB[i] = (unsigned)(Rb * K + C) * 2u; }
    const size_t kstep = (size_t)(BK * 2);
    const size_t hstep = (size_t)HALF * K * 2;
    const size_t tstep = 2 * hstep;
    const unsigned ldsw = (unsigned)wid * 1024u;
    const int aoff = lds_byte(wr * 64 + fr, fq * 8), boff = lds_byte(wc * 32 + fr, fq * 8);
#define PG8_SA(b, h) (((b) * 2 + (h)) * HTB)
#define PG8_SB(b, h) ((4 + (b) * 2 + (h)) * HTB)
#define PG8_STAGE(bufoff, gbase, voff) do { _Pragma("unroll") for (int _i = 0; _i < 2; ++_i) \
        __builtin_amdgcn_global_load_lds((const unsigned*)((const char*)(gbase) + (voff)[_i]), (PG8_LAS unsigned*)(lds + (bufoff) + ldsw + _i * 8192), 16, 0, 0); } while (0)
#define PG8_LDA(dst, b, h) do { _Pragma("unroll") for (int m = 0; m < 4; ++m) _Pragma("unroll") for (int k = 0; k < 2; ++k) dst[m][k] = *(const PG8_LAS bf16x8*)(lds + PG8_SA(b, h) + aoff + m * 2048 + k * 1024); } while (0)
#define PG8_LDB(dst, b, h) do { _Pragma("unroll") for (int n = 0; n < 2; ++n) _Pragma("unroll") for (int k = 0; k < 2; ++k) dst[n][k] = *(const PG8_LAS bf16x8*)(lds + PG8_SB(b, h) + boff + n * 2048 + k * 1024); } while (0)
#define PG8_MMA(ai, bj, At, Bt) do { __builtin_amdgcn_s_setprio(1); _Pragma("unroll") for (int m = 0; m < 4; ++m) _Pragma("unroll") for (int n = 0; n < 2; ++n) _Pragma("unroll") for (int k = 0; k < 2; ++k) \
        acc[ai][bj][m][n] = __builtin_amdgcn_mfma_f32_16x16x32_bf16(Bt[n][k], At[m][k], acc[ai][bj][m][n], 0, 0, 0); __builtin_amdgcn_s_setprio(0); } while (0)
#define PG8_WAIT_V(n) asm volatile("s_waitcnt vmcnt(" #n ")" ::: "memory")
#define PG8_WAIT_L(n) asm volatile("s_waitcnt lgkmcnt(" #n ")" ::: "memory")
#define PG8_BAR __builtin_amdgcn_s_barrier()
#define PG8_SCHED __builtin_amdgcn_sched_barrier(0)
    Unit cur, nxt; int ui = 0;
    if (!S.next(0, cur)) return;
    f32x4 acc[2][2][4][2];
#pragma unroll
    for (int a = 0; a < 2; ++a)
#pragma unroll
        for (int b = 0; b < 2; ++b)
#pragma unroll
            for (int m = 0; m < 4; ++m)
#pragma unroll
                for (int n = 0; n < 2; ++n) acc[a][b][m][n] = (f32x4){0.f, 0.f, 0.f, 0.f};
    bf16x8 At[4][2], B0[2][2], B1[2][2];
    const char* cA = (const char*)g.A + (size_t)cur.pm * tstep; const char* cB = (const char*)g.Bt + (size_t)cur.pn * tstep;
    S.a_ready(cur);
    if constexpr (SP2) {
        PG8_STAGE(PG8_SB(0, 0), cB, voffB); PG8_STAGE(PG8_SB(0, 1), cB + hstep, voffB); PG8_STAGE(PG8_SA(0, 0), cA, voffA); PG8_STAGE(PG8_SA(0, 1), cA + hstep, voffA);
        if (wr == 1) PG8_BAR;
        PG8_WAIT_V(2); PG8_BAR;
        PG8_STAGE(PG8_SB(1, 0), cB + kstep, voffB); PG8_STAGE(PG8_SA(1, 0), cA + kstep, voffA); PG8_STAGE(PG8_SB(1, 1), cB + hstep + kstep, voffB);
        PG8_WAIT_V(6); PG8_BAR;
    } else {
        PG8_STAGE(PG8_SB(0, 0), cB, voffB); PG8_STAGE(PG8_SA(0, 0), cA, voffA); PG8_STAGE(PG8_SB(0, 1), cB + hstep, voffB); PG8_STAGE(PG8_SA(0, 1), cA + hstep, voffA);
        if (wr == 1) PG8_BAR;
        PG8_WAIT_V(4); PG8_BAR;
        PG8_STAGE(PG8_SB(1, 0), cB + kstep, voffB); PG8_STAGE(PG8_SA(1, 0), cA + kstep, voffA); PG8_STAGE(PG8_SB(1, 1), cB + hstep + kstep, voffB);
        PG8_WAIT_V(6); PG8_BAR;
    }
    for (;;) {
        const bool has_next = S.next(ui + 1, nxt);
        const char* nA = has_next ? (const char*)g.A + (size_t)nxt.pm * tstep : cA; const char* nB = has_next ? (const char*)g.Bt + (size_t)nxt.pn * tstep : cB;
        for (int t = 0; t < nt; t += 2) {
            const bool last = (t == nt - 2);
            const char* a1 = cA + (size_t)(t + 1) * kstep;
            const char* a2 = last ? nA : cA + (size_t)(t + 2) * kstep; const char* b2 = last ? nB : cB + (size_t)(t + 2) * kstep;
            const char* a3 = a2 + kstep; const char* b3 = b2 + kstep;
            if (last && has_next) S.a_ready(nxt);
            if constexpr (SP2) {
            PG8_LDB(B0, 0, 0); PG8_LDB(B1, 0, 1); PG8_SCHED; PG8_LDA(At, 0, 0); PG8_STAGE(PG8_SA(1, 1), a1 + hstep, voffA);
            PG8_WAIT_V(8); PG8_WAIT_L(0); PG8_BAR; PG8_MMA(0, 0, At, B0); PG8_MMA(0, 1, At, B1); PG8_BAR; PG8_SCHED;
            PG8_LDA(At, 0, 1); PG8_STAGE(PG8_SB(0, 0), b2, voffB); PG8_STAGE(PG8_SB(0, 1), b2 + hstep, voffB); PG8_STAGE(PG8_SA(0, 0), a2, voffA);
            PG8_WAIT_V(8); PG8_WAIT_L(0); PG8_BAR; PG8_MMA(1, 0, At, B0); PG8_MMA(1, 1, At, B1); PG8_BAR; PG8_SCHED;
            PG8_LDB(B0, 1, 0); PG8_LDB(B1, 1, 1); PG8_SCHED; PG8_LDA(At, 1, 0); PG8_STAGE(PG8_SA(0, 1), a2 + hstep, voffA);
            PG8_WAIT_V(8); PG8_WAIT_L(0); PG8_BAR; PG8_MMA(0, 0, At, B0); PG8_MMA(0, 1, At, B1); PG8_BAR; PG8_SCHED;
            PG8_LDA(At, 1, 1); PG8_STAGE(PG8_SB(1, 0), b3, voffB); PG8_STAGE(PG8_SB(1, 1), b3 + hstep, voffB); PG8_STAGE(PG8_SA(1, 0), a3, voffA);
            PG8_WAIT_V(8); PG8_WAIT_L(0); PG8_BAR; PG8_MMA(1, 0, At, B0); PG8_MMA(1, 1, At, B1); PG8_BAR; PG8_SCHED;
            } else {
            PG8_LDB(B0, 0, 0); PG8_SCHED; PG8_LDA(At, 0, 0); PG8_STAGE(PG8_SA(1, 1), a1 + hstep, voffA);
            PG8_WAIT_L(8); PG8_BAR; PG8_WAIT_L(0); PG8_MMA(0, 0, At, B0); PG8_BAR; PG8_SCHED;
            PG8_LDB(B1, 0, 1); PG8_STAGE(PG8_SB(0, 0), b2, voffB);
            PG8_BAR; PG8_WAIT_L(0); PG8_MMA(0, 1, At, B1); PG8_BAR;
            PG8_LDA(At, 0, 1); PG8_STAGE(PG8_SA(0, 0), a2, voffA);
            PG8_BAR; PG8_WAIT_L(0); PG8_MMA(1, 0, At, B0); PG8_BAR; PG8_SCHED;
            PG8_STAGE(PG8_SB(0, 1), b2 + hstep, voffB);
            PG8_WAIT_V(6); PG8_BAR; PG8_MMA(1, 1, At, B1); PG8_BAR;
            PG8_LDB(B0, 1, 0); PG8_SCHED; PG8_LDA(At, 1, 0); PG8_STAGE(PG8_SA(0, 1), a2 + hstep, voffA);
            PG8_WAIT_L(8); PG8_BAR; PG8_WAIT_L(0); PG8_MMA(0, 0, At, B0); PG8_BAR; PG8_SCHED;
            PG8_LDB(B1, 1, 1); PG8_STAGE(PG8_SB(1, 0), b3, voffB);
            PG8_BAR; PG8_WAIT_L(0); PG8_MMA(0, 1, At, B1); PG8_BAR;
            PG8_LDA(At, 1, 1); PG8_STAGE(PG8_SA(1, 0), a3, voffA);
            PG8_BAR; PG8_WAIT_L(0); PG8_MMA(1, 0, At, B0); PG8_BAR; PG8_SCHED;
            PG8_STAGE(PG8_SB(1, 1), b3 + hstep, voffB);
            PG8_WAIT_V(6); PG8_BAR; PG8_MMA(1, 1, At, B1); PG8_BAR;
            }
        }
        if constexpr (ALIGN_EPI) { if (wr == 0) PG8_BAR; }
        if constexpr (!Epi::AFTER_DRAIN) { E(acc, cur, wr, wc, fr, fq); S.done(cur); }
        if (!has_next) break;
#pragma unroll
        for (int a = 0; a < 2; ++a)
#pragma unroll
            for (int b = 0; b < 2; ++b)
#pragma unroll
                for (int m = 0; m < 4; ++m)
#pragma unroll
                    for (int n = 0; n < 2; ++n) acc[a][b][m][n] = (f32x4){0.f, 0.f, 0.f, 0.f};
        cur = nxt; cA = nA; cB = nB; ++ui;
        if constexpr (ALIGN_EPI) { if (wr == 1) PG8_BAR; }
    }
    PG8_WAIT_V(0);
    if constexpr (!ALIGN_EPI) { if (wr == 0) PG8_BAR; }
    PG8_BAR;
    if constexpr (Epi::AFTER_DRAIN) { E.fused(acc, cur, wr, wc, fr, fq, lds, wid, lane); S.done(cur); }
#undef PG8_SA
#undef PG8_SB
#undef PG8_STAGE
#undef PG8_LDA
#undef PG8_LDB
#undef PG8_MMA
#undef PG8_WAIT_V
#undef PG8_WAIT_L
#undef PG8_BAR
#undef PG8_SCHED
}
}

#include <hip/hip_cooperative_groups.h>
namespace cg = cooperative_groups;

#define LAS __attribute__((address_space(3)))
typedef unsigned short bf16;
typedef unsigned v4u __attribute__((ext_vector_type(4)));
typedef unsigned v2u __attribute__((ext_vector_type(2)));
typedef float f32x4 __attribute__((ext_vector_type(4)));
typedef short bf16x8 __attribute__((ext_vector_type(8)));
typedef short s16x4 __attribute__((ext_vector_type(4)));

constexpr int NWAVES = 8, NT = NWAVES * 64;
constexpr int BATCH = 4, SEQ = 4096, D = 1024, M = BATCH * SEQ, FF = 4096, NH = 16, HD = 64, GW = 64, ROWS = 64, KH = 8, WW = 16;
constexpr size_t MiB = 1u << 20;
constexpr size_t WS_BAR = 0;
constexpr int BARST_OFF = 139264;
constexpr size_t WS_SSQ = 1 * MiB;
constexpr size_t WS_WIN = 4 * MiB, WS_WOUT = 10 * MiB, WS_WQKV = 12 * MiB, WS_WO = 18 * MiB, WS_WUP0 = 20 * MiB, WS_WUP1 = 28 * MiB, WS_WDN0 = 36 * MiB, WS_WDN1 = 44 * MiB;
constexpr size_t WS_XB = 52 * MiB;
constexpr size_t WS_U = 84 * MiB;
constexpr size_t WS_Y = 180 * MiB;
constexpr size_t WS_A = 84 * MiB;
constexpr size_t WS_END = 212 * MiB;
constexpr int LDS_BYTES = 151552;

__device__ __forceinline__ unsigned f2bf(float f) { unsigned u = __builtin_bit_cast(unsigned, f); return (u + 0x7fffu + ((u >> 16) & 1u)) >> 16; }
__device__ __forceinline__ unsigned pk2(float lo, float hi) { return f2bf(lo) | (f2bf(hi) << 16); }
__device__ __forceinline__ float bf_lo(unsigned w) { return __builtin_bit_cast(float, w << 16); }
__device__ __forceinline__ float bf_hi(unsigned w) { return __builtin_bit_cast(float, w & 0xffff0000u); }
#define LDS_WAIT() asm volatile("s_waitcnt lgkmcnt(0)" ::: "memory")

__device__ __forceinline__ float wave_sum(float v) {
#pragma unroll
    for (int o = 1; o < 64; o <<= 1) v += __shfl_xor(v, o);
    return v;
}

__device__ __forceinline__ void p0_transpose_item(const float* W, int K, int N, bf16* WT, const float* g, LAS float* scr, int item, int lane) {
    const int nblk = N / 32, kb = item / nblk, nb = item % nblk, k0 = 64 * kb, n0 = 32 * nb;
#pragma unroll 8
    for (int i = 0; i < 32; ++i) { const int kk = 2 * i + (lane >> 5); float w = W[(size_t)(k0 + kk) * N + n0 + (lane & 31)]; if (g) w *= g[k0 + kk]; scr[kk * 33 + (lane & 31)] = w; }
    LDS_WAIT(); asm volatile("" ::: "memory");
    const int c = lane & 7;
#pragma unroll
    for (int j = 0; j < 4; ++j) { const int n = (lane >> 3) + 8 * j; const LAS float* s = scr + (8 * c) * 33 + n;
        v4u o; o.x = pk2(s[0 * 33], s[1 * 33]); o.y = pk2(s[2 * 33], s[3 * 33]); o.z = pk2(s[4 * 33], s[5 * 33]); o.w = pk2(s[6 * 33], s[7 * 33]);
        *(v4u*)(WT + (size_t)(n0 + n) * K + k0 + 8 * c) = o; }
    LDS_WAIT(); asm volatile("" ::: "memory");
}

#define XB_TMO      128
#define XB_XCNT(j)  (256  + 64 * (j))
#define XB_XSUB(j)  (1280 + 64 * (j))
#define XB_XGEN(j)  (2304 + 64 * (j))
#define XB_TOP      3328
#define XB_TOPGEN   3392
#define XCD_BAR_WORDS 3456
#define XB_SPIN_CAP (1u << 18)

__device__ __forceinline__ unsigned xb_ld(unsigned* p)              { return __hip_atomic_load(p, __ATOMIC_RELAXED, __HIP_MEMORY_SCOPE_AGENT); }
__device__ __forceinline__ unsigned xb_add(unsigned* p, unsigned v) { return __hip_atomic_fetch_add(p, v, __ATOMIC_RELAXED, __HIP_MEMORY_SCOPE_AGENT); }
__device__ __forceinline__ unsigned xb_xcc_id() { return (unsigned)__builtin_amdgcn_s_getreg((3 << 11) | 20) & 0xFu; }
#define XB_SPIN(cond, bar) do { unsigned _sp = 0; while (cond) { __builtin_amdgcn_s_sleep(1); \
    if ((++_sp & 255u) == 0u) { if (xb_ld(&(bar)[XB_TMO])) break; if (_sp > XB_SPIN_CAP) { atomicAdd(&(bar)[XB_TMO], 1u); break; } } } } while (0)

struct XcdBarrier {
    unsigned* bar; unsigned x;
    volatile LAS unsigned* st;
};

__device__ __forceinline__ XcdBarrier xcd_barrier_post(unsigned* bar, volatile LAS unsigned* st) {
    XcdBarrier b; b.bar = bar; b.x = xb_xcc_id(); b.st = st;
    if (threadIdx.x == 0) (void)xb_add(&bar[XB_XCNT(b.x)], 1u);
    return b;
}
__device__ __forceinline__ void xcd_barrier_complete(unsigned* bar, unsigned x, unsigned& nloc, unsigned& nx) {
    const unsigned G = gridDim.x * gridDim.y * gridDim.z;
    unsigned sum, cnt, mine, sp = 0u;
    for (;;) {
        sum = 0u; cnt = 0u; mine = 0u;
#pragma unroll
        for (unsigned j = 0; j < 16; ++j) { const unsigned c = xb_ld(&bar[XB_XCNT(j)]); sum += c; cnt += (c > 0u) ? 1u : 0u; mine = (j == x) ? c : mine; }
        if (sum == G) break;
        __builtin_amdgcn_s_sleep(1);
        if ((++sp & 255u) == 0u) { if (xb_ld(&bar[XB_TMO])) break; if (sp > XB_SPIN_CAP) { atomicAdd(&bar[XB_TMO], 1u); break; } }
    }
    nloc = mine > 0u ? mine : 1u; nx = cnt > 0u ? cnt : 1u;
}

__device__ __forceinline__ void xcd_barrier(const XcdBarrier& b) {
    asm volatile("s_waitcnt vmcnt(0)" ::: "memory");
    __syncthreads();
    if (threadIdx.x == 0) {
        unsigned* bar = b.bar;
        __builtin_amdgcn_s_waitcnt(0);
        unsigned nloc = b.st[0], nx = b.st[1];
        if (nloc == 0u) { xcd_barrier_complete(bar, b.x, nloc, nx); b.st[0] = nloc; b.st[1] = nx; }
        const unsigned old = xb_add(&bar[XB_XSUB(b.x)], 1u);
        const unsigned gen = old / nloc;
        if (old + 1u == (gen + 1u) * nloc) {
            __builtin_amdgcn_fence(__ATOMIC_RELEASE, "agent");
            asm volatile("s_waitcnt vmcnt(0)" ::: "memory");
            const unsigned og = xb_add(&bar[XB_TOP], 1u);
            const unsigned tg = og / nx;
            if (og + 1u == (tg + 1u) * nx) xb_add(&bar[XB_TOPGEN], 1u);
            else XB_SPIN(xb_ld(&bar[XB_TOPGEN]) == tg, bar);
            __builtin_amdgcn_fence(__ATOMIC_ACQUIRE, "agent");
            xb_add(&bar[XB_XGEN(b.x)], 1u);
            asm volatile("s_waitcnt vmcnt(0)" ::: "memory");
        } else {
            XB_SPIN(xb_ld(&bar[XB_XGEN(b.x)]) == gen, bar);
            __builtin_amdgcn_fence(__ATOMIC_ACQUIRE, "agent");
            asm volatile("s_waitcnt vmcnt(0)" ::: "memory");
        }
    }
    __syncthreads();
}

struct Args {
    const float* x; const float* norm_mix; const float* conv_w_in; const float* conv_w; const float* conv_w_out; const float* attn_w_qkv; const float* attn_rpb; const float* attn_w_o;
    const float* norm_mlp; const float* mlp_w_up; const float* mlp_w_down; const float* norm_final; float* out; unsigned char* ws;
};

__device__ __forceinline__ void p0_prologue(const Args& a, LAS unsigned char* lds, int gw, int NGW, int wave, int lane) {
    LAS float* scr = (LAS float*)(lds + wave * 16384);
    unsigned char* ws = a.ws;
    constexpr int I_IN = 16 * 96, I_SQ = 16 * 32, I_UP = 16 * 128, I_DN = 64 * 32;
    constexpr int NITEMS = 2 * I_IN + 2 * I_SQ + 2 * I_UP + 2 * I_DN;
    for (int it = gw; it < NITEMS; it += NGW) {
        int r = it;
        if (r < I_IN) { p0_transpose_item(a.conv_w_in, D, 3 * D, (bf16*)(ws + WS_WIN), a.norm_mix, scr, r, lane); continue; } r -= I_IN;
        if (r < I_IN) { p0_transpose_item(a.attn_w_qkv, D, 3 * D, (bf16*)(ws + WS_WQKV), a.norm_mix + D, scr, r, lane); continue; } r -= I_IN;
        if (r < I_SQ) { p0_transpose_item(a.conv_w_out, D, D, (bf16*)(ws + WS_WOUT), nullptr, scr, r, lane); continue; } r -= I_SQ;
        if (r < I_SQ) { p0_transpose_item(a.attn_w_o, D, D, (bf16*)(ws + WS_WO), nullptr, scr, r, lane); continue; } r -= I_SQ;
        if (r < I_UP) { p0_transpose_item(a.mlp_w_up, D, FF, (bf16*)(ws + WS_WUP0), a.norm_mlp, scr, r, lane); continue; } r -= I_UP;
        if (r < I_UP) { p0_transpose_item(a.mlp_w_up + (size_t)D * FF, D, FF, (bf16*)(ws + WS_WUP1), a.norm_mlp + D, scr, r, lane); continue; } r -= I_UP;
        if (r < I_DN) { p0_transpose_item(a.mlp_w_down, FF, D, (bf16*)(ws + WS_WDN0), nullptr, scr, r, lane); continue; } r -= I_DN;
        p0_transpose_item(a.mlp_w_down + (size_t)FF * D, FF, D, (bf16*)(ws + WS_WDN1), nullptr, scr, r, lane);
    }
    bf16* XB = (bf16*)(ws + WS_XB); float* SSQ = (float*)(ws + WS_SSQ);
    for (int m = gw; m < M; m += NGW) {
        const f32x4* xr = (const f32x4*)(a.x + (size_t)m * D) + lane; f32x4 v[4]; float s = 0.f;
#pragma unroll
        for (int j = 0; j < 4; ++j) { v[j] = xr[64 * j]; s += (v[j].x * v[j].x + v[j].y * v[j].y) + (v[j].z * v[j].z + v[j].w * v[j].w); }
        s = wave_sum(s);
        v2u* o8 = (v2u*)(XB + (size_t)m * D) + lane;
#pragma unroll
        for (int j = 0; j < 4; ++j) { v2u o; o.x = pk2(v[j].x, v[j].y); o.y = pk2(v[j].z, v[j].w); o8[64 * j] = o; }
        if (lane < 16) SSQ[(size_t)m * 16 + lane] = (lane == 0) ? s : 0.f;
    }
}

__device__ __forceinline__ void conv_phase(const Args& a, int gw, int NGW, int lane) {
    const bf16* U = (const bf16*)(a.ws + WS_U); bf16* Y = (bf16*)(a.ws + WS_Y);
    constexpr int TCH = 16, NTASK = (M / TCH) * 2;
    for (int task = gw; task < NTASK; task += NGW) {
        const int ch = task >> 1, hf = task & 1, t0 = ch * TCH, d0 = hf * 512 + lane * 8;
        float w0[8], w1[8], w2[8];
#pragma unroll
        for (int e = 0; e < 8; ++e) { w0[e] = a.conv_w[d0 + e]; w1[e] = a.conv_w[D + d0 + e]; w2[e] = a.conv_w[2 * D + d0 + e]; }
        float zp[8], zc[8], zn[8];
        auto loadz = [&](int t, float* z) {
            const v4u c = *(const v4u*)(U + (size_t)t * (3 * D) + D + d0), v = *(const v4u*)(U + (size_t)t * (3 * D) + 2 * D + d0);
            z[0] = bf_lo(c.x) * bf_lo(v.x); z[1] = bf_hi(c.x) * bf_hi(v.x); z[2] = bf_lo(c.y) * bf_lo(v.y); z[3] = bf_hi(c.y) * bf_hi(v.y);
            z[4] = bf_lo(c.z) * bf_lo(v.z); z[5] = bf_hi(c.z) * bf_hi(v.z); z[6] = bf_lo(c.w) * bf_lo(v.w); z[7] = bf_hi(c.w) * bf_hi(v.w); };
        if ((t0 & (SEQ - 1)) == 0) {
#pragma unroll
            for (int e = 0; e < 8; ++e) zp[e] = 0.f; } else loadz(t0 - 1, zp);
        loadz(t0, zc);
        for (int i = 0; i < TCH; ++i) {
            const int t = t0 + i;
            if (((t + 1) & (SEQ - 1)) == 0) {
#pragma unroll
                for (int e = 0; e < 8; ++e) zn[e] = 0.f; } else loadz(t + 1, zn);
            const v4u bb = *(const v4u*)(U + (size_t)t * (3 * D) + d0);
            float bv[8] = {bf_lo(bb.x), bf_hi(bb.x), bf_lo(bb.y), bf_hi(bb.y), bf_lo(bb.z), bf_hi(bb.z), bf_lo(bb.w), bf_hi(bb.w)};
            float y[8];
#pragma unroll
            for (int e = 0; e < 8; ++e) y[e] = bv[e] * (w0[e] * zp[e] + w1[e] * zc[e] + w2[e] * zn[e]);
            v4u o; o.x = pk2(y[0], y[1]); o.y = pk2(y[2], y[3]); o.z = pk2(y[4], y[5]); o.w = pk2(y[6], y[7]);
            *(v4u*)(Y + (size_t)t * D + d0) = o;
#pragma unroll
            for (int e = 0; e < 8; ++e) { zp[e] = zc[e]; zc[e] = zn[e]; }
        }
    }
}

__device__ __forceinline__ int swz(int col) { return ((col >> 1) & 1) | (((col >> 3) & 3) << 1); }
__device__ __forceinline__ void attn_load_row(const bf16* QKV, LAS unsigned char* Kl, LAS unsigned char* Vl, int b, int h, int row, int tid) {
    const int col = tid >> 3, chunk = tid & 7; const size_t tok = (size_t)b * SEQ + row * GW + col;
    const v4u k = *(const v4u*)(QKV + tok * (3 * D) + D + h * HD + chunk * 8), v = *(const v4u*)(QKV + tok * (3 * D) + 2 * D + h * HD + chunk * 8);
    const int off = (((row & 7) * 64 + col) << 7) + ((chunk ^ swz(col)) << 4);
    *(LAS v4u*)(Kl + off) = k; *(LAS v4u*)(Vl + off) = v;
}
__device__ __forceinline__ void attn_phase(const Args& a, LAS unsigned char* lds, int G, int bid, int tid) {
    const bf16* QKV = (const bf16*)(a.ws + WS_U); bf16* Y = (bf16*)(a.ws + WS_Y);
    LAS unsigned char* Kl = lds; LAS unsigned char* Vl = lds + 65536; LAS float* Bl = (LAS float*)(lds + 131072);
    const int wave = __builtin_amdgcn_readfirstlane(tid >> 6), lane = tid & 63, g = lane >> 4, qi = lane & 15;
    for (int st = bid; st < BATCH * NH * 4; st += G) {
        const int b = st >> 6, h = (st >> 2) & 15, seg = st & 3, r0 = seg * 16;
        __syncthreads();
        for (int i = tid; i < 15 * 31; i += NT) Bl[i] = a.attn_rpb[h * 465 + i];
        int s_prev = min(max(r0 - 4, 0), ROWS - KH);
        for (int i = 0; i < 8; ++i) attn_load_row(QKV, Kl, Vl, b, h, s_prev + i, tid);
        __syncthreads();
        for (int r = r0; r < r0 + 16; ++r) {
            const int s = min(max(r - 4, 0), ROWS - KH);
            if (s != s_prev) { attn_load_row(QKV, Kl, Vl, b, h, s + 7, tid); s_prev = s; __syncthreads(); }
            if (wave < 4) {
                const int j = wave, c0 = (j == 0) ? 0 : (j == 1) ? 8 : (j == 2) ? 24 : 32;
                const int c = 16 * j + qi, cs = min(max(c - 8, 0), GW - WW);
                const size_t qtok = (size_t)b * SEQ + r * GW + c;
                const bf16x8 q0 = *(const bf16x8*)(QKV + qtok * (3 * D) + h * HD + g * 8), q1 = *(const bf16x8*)(QKV + qtok * (3 * D) + h * HD + 32 + g * 8);
                f32x4 sc[8][2];
                const int kcolA = c0 + 8 * (qi >> 2) + (qi & 3);
                float mx = -INFINITY;
#pragma unroll
                for (int i = 0; i < 8; ++i) {
                    const int slot = (s + i) & 7;
#pragma unroll
                    for (int T = 0; T < 2; ++T) {
                        const int kc = kcolA + 4 * T; const int base = ((slot * 64 + kc) << 7), sw = swz(kc);
                        const bf16x8 k0 = *(const LAS bf16x8*)(Kl + base + ((g ^ sw) << 4)), k1 = *(const LAS bf16x8*)(Kl + base + (((4 + g) ^ sw) << 4));
                        f32x4 acc = (f32x4){0.f, 0.f, 0.f, 0.f};
                        acc = __builtin_amdgcn_mfma_f32_16x16x32_bf16(k0, q0, acc, 0, 0, 0);
                        acc = __builtin_amdgcn_mfma_f32_16x16x32_bf16(k1, q1, acc, 0, 0, 0);
                        const int roff = (s + i - r + 7) * 31;
#pragma unroll
                        for (int e = 0; e < 4; ++e) {
                            const int kcol = c0 + 8 * g + 4 * T + e; const bool ok = (kcol >= cs) && (kcol < cs + WW);
                            const float bias = Bl[ok ? roff + (kcol - c + 15) : 0];
                            const float v = ok ? acc[e] * 0.125f + bias : -INFINITY;
                            acc[e] = v; mx = fmaxf(mx, v); }
                        sc[i][T] = acc;
                    }
                }
                mx = fmaxf(mx, __shfl_xor(mx, 16)); mx = fmaxf(mx, __shfl_xor(mx, 32));
                float sum = 0.f;
#pragma unroll
                for (int i = 0; i < 8; ++i)
#pragma unroll
                    for (int T = 0; T < 2; ++T)
#pragma unroll
                        for (int e = 0; e < 4; ++e) { const float p = __builtin_amdgcn_exp2f((sc[i][T][e] - mx) * 1.4426950408889634f); sc[i][T][e] = p; sum += p; }
                sum += __shfl_xor(sum, 16); sum += __shfl_xor(sum, 32);
                f32x4 o[4];
#pragma unroll
                for (int dt = 0; dt < 4; ++dt) o[dt] = (f32x4){0.f, 0.f, 0.f, 0.f};
                const int vq = qi >> 2, vp = qi & 3, vcol = c0 + 8 * g + vq, vsw = swz(vcol);
#pragma unroll
                for (int i = 0; i < 8; ++i) {
                    const int slot = (s + i) & 7;
                    v4u pw; pw.x = pg8::cvt_pk_bf16(sc[i][0][0], sc[i][0][1]); pw.y = pg8::cvt_pk_bf16(sc[i][0][2], sc[i][0][3]); pw.z = pg8::cvt_pk_bf16(sc[i][1][0], sc[i][1][1]); pw.w = pg8::cvt_pk_bf16(sc[i][1][2], sc[i][1][3]);
                    const bf16x8 pf = __builtin_bit_cast(bf16x8, pw);
                    const int vbase = ((slot * 64 + vcol) << 7) + (vp & 1) * 8;
#pragma unroll
                    for (int dt = 0; dt < 4; ++dt) {
                        const int ch = ((dt * 2 + (vp >> 1)) ^ vsw) << 4;
                        const s16x4 lo = __builtin_bit_cast(s16x4, __builtin_amdgcn_ds_read_tr16_b64_v4i16((LAS s16x4*)(Vl + vbase + ch)));
                        const s16x4 hi = __builtin_bit_cast(s16x4, __builtin_amdgcn_ds_read_tr16_b64_v4i16((LAS s16x4*)(Vl + vbase + ch + 512)));
                        bf16x8 vf; vf[0] = lo[0]; vf[1] = lo[1]; vf[2] = lo[2]; vf[3] = lo[3]; vf[4] = hi[0]; vf[5] = hi[1]; vf[6] = hi[2]; vf[7] = hi[3];
                        o[dt] = __builtin_amdgcn_mfma_f32_16x16x32_bf16(vf, pf, o[dt], 0, 0, 0);
                    }
                }
                const float inv = 1.0f / sum;
                bf16* yp = Y + qtok * D + h * HD + 4 * g;
#pragma unroll
                for (int dt = 0; dt < 4; ++dt) { v2u w; w.x = pg8::cvt_pk_bf16(o[dt][0] * inv, o[dt][1] * inv); w.y = pg8::cvt_pk_bf16(o[dt][2] * inv, o[dt][3] * inv); *(v2u*)(yp + dt * 16) = w; }
            }
            __syncthreads();
        }
    }
}

__device__ __forceinline__ void final_norm(const Args& a, int gw, int NGW, int lane) {
    const float* SSQ = (const float*)(a.ws + WS_SSQ);
    f32x4 gv[4];
#pragma unroll
    for (int j = 0; j < 4; ++j) gv[j] = ((const f32x4*)a.norm_final)[lane + 64 * j];
    for (int m = gw; m < M; m += NGW) {
        const float rs = pg8::row_rstd(SSQ, m);
        f32x4* xr = (f32x4*)(a.out + (size_t)m * D) + lane;
#pragma unroll
        for (int j = 0; j < 4; ++j) { f32x4 v = xr[64 * j]; v = v * rs * gv[j]; xr[64 * j] = v; }
    }
}

__global__ void __launch_bounds__(NT) fwd_megakernel(Args a) {
    extern __shared__ __attribute__((aligned(16))) unsigned char lds_raw[];
    LAS unsigned char* lds = (LAS unsigned char*)lds_raw;
    cg::grid_group grid = cg::this_grid();
    const int tid = threadIdx.x, lane = tid & 63, wave = __builtin_amdgcn_readfirstlane(tid >> 6);
    const int G = gridDim.x, bid = blockIdx.x, gw = bid * NWAVES + wave, NGW = G * NWAVES;
    unsigned char* ws = a.ws;
    bf16* XB = (bf16*)(ws + WS_XB); bf16* U = (bf16*)(ws + WS_U); bf16* Y = (bf16*)(ws + WS_Y); bf16* A = (bf16*)(ws + WS_A); float* SSQ = (float*)(ws + WS_SSQ);

    if (bid == 0) for (int i = tid; i < XCD_BAR_WORDS; i += NT) __hip_atomic_store((unsigned*)(ws + WS_BAR) + i, 0u, __ATOMIC_RELAXED, __HIP_MEMORY_SCOPE_AGENT);
    if (tid < 2) ((volatile LAS unsigned*)(lds + BARST_OFF))[tid] = 0u;
    p0_prologue(a, lds, gw, NGW, wave, lane);
    grid.sync();
    const XcdBarrier bar = xcd_barrier_post((unsigned*)(ws + WS_BAR), (volatile LAS unsigned*)(lds + BARST_OFF));
    { pg8::Gemm g{XB, (const bf16*)(ws + WS_WIN), M, 3 * D, D}; pg8::StaticOrder S; S.init(M, 3 * D, G, bid); pg8::EpiScale<0> E{U, 3 * D, SSQ};
      pg8::gemm_phase<pg8::EpiScale<0>, pg8::StaticOrder, true, true>(lds, g, S, E); }
    xcd_barrier(bar);
    conv_phase(a, gw, NGW, lane);
    xcd_barrier(bar);
    { pg8::Gemm g{Y, (const bf16*)(ws + WS_WOUT), M, D, D}; pg8::StaticOrder S; S.init(M, D, G, bid); pg8::EpiResid E{a.x, a.out, XB, SSQ};
      pg8::gemm_phase<pg8::EpiResid, pg8::StaticOrder, true, true>(lds, g, S, E); }
    xcd_barrier(bar);
    { pg8::Gemm g{XB, (const bf16*)(ws + WS_WUP0), M, FF, D}; pg8::StaticOrder S; S.init(M, FF, G, bid); pg8::EpiScale<1> E{A, FF, SSQ};
      pg8::gemm_phase<pg8::EpiScale<1>, pg8::StaticOrder, true, true>(lds, g, S, E); }
    xcd_barrier(bar);
    { pg8::Gemm g{A, (const bf16*)(ws + WS_WDN0), M, D, FF}; pg8::StaticOrder S; S.init(M, D, G, bid); pg8::EpiResid E{a.out, a.out, XB, SSQ};
      pg8::gemm_phase<pg8::EpiResid, pg8::StaticOrder, true, true>(lds, g, S, E); }
    xcd_barrier(bar);
    { pg8::Gemm g{XB, (const bf16*)(ws + WS_WQKV), M, 3 * D, D}; pg8::StaticOrder S; S.init(M, 3 * D, G, bid); pg8::EpiScale<0> E{U, 3 * D, SSQ};
      pg8::gemm_phase<pg8::EpiScale<0>, pg8::StaticOrder, true, true>(lds, g, S, E); }
    xcd_barrier(bar);
    attn_phase(a, lds, G, bid, tid);
    xcd_barrier(bar);
    { pg8::Gemm g{Y, (const bf16*)(ws + WS_WO), M, D, D}; pg8::StaticOrder S; S.init(M, D, G, bid); pg8::EpiResid E{a.out, a.out, XB, SSQ};
      pg8::gemm_phase<pg8::EpiResid, pg8::StaticOrder, true, true>(lds, g, S, E); }
    xcd_barrier(bar);
    { pg8::Gemm g{XB, (const bf16*)(ws + WS_WUP1), M, FF, D}; pg8::StaticOrder S; S.init(M, FF, G, bid); pg8::EpiScale<1> E{A, FF, SSQ};
      pg8::gemm_phase<pg8::EpiScale<1>, pg8::StaticOrder, true, true>(lds, g, S, E); }
    xcd_barrier(bar);
    { pg8::Gemm g{A, (const bf16*)(ws + WS_WDN1), M, D, FF}; pg8::StaticOrder S; S.init(M, D, G, bid); pg8::EpiResid E{a.out, a.out, nullptr, SSQ};
      pg8::gemm_phase<pg8::EpiResid, pg8::StaticOrder, true, true>(lds, g, S, E); }
    xcd_barrier(bar);
    final_norm(a, gw, NGW, lane);
}

extern "C" void kernel_launch(void* const* d_in, const int* in_sizes, int n_in, void* d_out, int out_size, void* d_ws, size_t ws_size, hipStream_t stream) {
    static int grid = 0;
    if (grid == 0) {
        if (n_in != 12 || in_sizes[0] != M * D || out_size != M * D || ws_size < WS_END) { fprintf(stderr, "kernel_launch: unexpected shapes (n_in %d, in0 %d, out %d, ws %zu)\n", n_in, n_in > 0 ? in_sizes[0] : -1, out_size, ws_size); grid = -1; return; }
        int dev = 0, cus = 0, per_cu = 0;
        (void)hipGetDevice(&dev); (void)hipDeviceGetAttribute(&cus, hipDeviceAttributeMultiprocessorCount, dev);
        (void)hipFuncSetAttribute((const void*)fwd_megakernel, hipFuncAttributeMaxDynamicSharedMemorySize, LDS_BYTES);
        (void)hipOccupancyMaxActiveBlocksPerMultiprocessor(&per_cu, (const void*)fwd_megakernel, NT, LDS_BYTES);
        if (per_cu < 1) { fprintf(stderr, "kernel_launch: occupancy query says %d blocks per CU\n", per_cu); per_cu = 1; }
        (void)hipGetLastError();
        grid = cus * per_cu;
    }
    if (grid < 0) return;
    Args a{};
    a.x = (const float*)d_in[0]; a.norm_mix = (const float*)d_in[1]; a.conv_w_in = (const float*)d_in[2]; a.conv_w = (const float*)d_in[3]; a.conv_w_out = (const float*)d_in[4];
    a.attn_w_qkv = (const float*)d_in[5]; a.attn_rpb = (const float*)d_in[6]; a.attn_w_o = (const float*)d_in[7]; a.norm_mlp = (const float*)d_in[8]; a.mlp_w_up = (const float*)d_in[9];
    a.mlp_w_down = (const float*)d_in[10]; a.norm_final = (const float*)d_in[11]; a.out = (float*)d_out; a.ws = (unsigned char*)d_ws;
    void* args[] = {&a};
    hipError_t e = hipLaunchCooperativeKernel((const void*)fwd_megakernel, dim3(grid), dim3(NT), args, LDS_BYTES, stream);
    if (e != hipSuccess) fprintf(stderr, "kernel_launch: cooperative launch failed: %s (grid %d)\n", hipGetErrorString(e), grid);
}
```

```cpp
#include <hip/hip_runtime.h>
#include <cstdio>
#include <cstdint>
namespace pg8 {
#define PG8_LAS __attribute__((address_space(3)))
typedef unsigned short bf16_t;
typedef short bf16x8 __attribute__((ext_vector_type(8)));
typedef float f32x4 __attribute__((ext_vector_type(4)));
typedef unsigned u32x4 __attribute__((ext_vector_type(4)));
constexpr int BM = 256, BK = 64, HALF = 128, HTB = HALF * BK * 2  , STAGE_BYTES = 8 * HTB, NXCD = 8, WGM = 8;

__host__ __device__ __forceinline__ int lds_byte(int r, int c) { const int st = (r >> 4) * 2 + (c >> 5), rr = r & 15, cc = c & 31, ob = rr * 64 + cc * 2; return st * 1024 + (ob ^ (((ob >> 9) & 1) << 5)); }
__host__ __device__ __forceinline__ void stage_rc(int b, int& R, int& C) { const int st = b / 1024, sb = b % 1024, swz = sb ^ (((sb >> 9) & 1) << 5); R = (st >> 1) * 16 + swz / 64; C = (st & 1) * 32 + (swz % 64) / 2; }
__host__ __device__ __forceinline__ int perm32(int rho) { const int n = rho >> 4, i = rho & 15; return 8 * (i >> 2) + 4 * n + (i & 3); }

struct Unit { int pm, pn; };
struct Gemm { const bf16_t* A; const bf16_t* Bt; int M, N, K; };

struct StaticOrder {
    int nM, nN, nwg, G, c;
    __host__ __device__ void init(int M, int N, int G_, int c_) { nM = M / BM; nN = N / BM; nwg = nM * nN; G = G_; c = c_; }
    __host__ __device__ bool next(int i, Unit& u) const {
        const long L = (long)i * G + c; if (L >= nwg) return false;
        int wgid = (int)L; { const int q = nwg / NXCD, r = nwg % NXCD, xcd = wgid % NXCD, off = wgid / NXCD; wgid = (xcd < r ? xcd * (q + 1) : r * (q + 1) + (xcd - r) * q) + off; }
        const int nig = WGM * nN, gid = wgid / nig, fm = gid * WGM, gsz = (nM - fm) < WGM ? (nM - fm) : WGM;
        u.pm = fm + ((wgid % nig) % gsz); u.pn = (wgid % nig) / gsz; return true;
    }
    __device__ __forceinline__ void a_ready(const Unit&) const {}
    __device__ __forceinline__ void done(const Unit&) const {}
};

__device__ __forceinline__ unsigned cvt_pk_bf16(float lo, float hi) { unsigned r; asm volatile("v_cvt_pk_bf16_f32 %0, %1, %2" : "=v"(r) : "v"(lo), "v"(hi)); return r; }
typedef float f32x2 __attribute__((ext_vector_type(2)));

__device__ __forceinline__ float row_rstd(const float* ssq, int row) {
    const f32x4* p = (const f32x4*)(ssq + (size_t)row * 16);
    const f32x4 a = p[0], b = p[1], c = p[2], d = p[3];
    const f32x4 s = (a + b) + (c + d);
    const float t = (s[0] + s[1]) + (s[2] + s[3]);
    return 1.0f / sqrtf(t * (1.0f / 1024.0f) + 1e-6f);
}
template <int ACT> struct EpiScale {
    static constexpr bool PERM = true, AFTER_DRAIN = false;
    bf16_t* O; int ldc; const float* ssq;
    __device__ __forceinline__ void operator()(const f32x4 (&acc)[2][2][4][2], const Unit& u, int wr, int wc, int fr, int fq) const {
        const int row0 = u.pm * BM + wr * 64 + fr; const int col0 = u.pn * BM + wc * 32 + 8 * fq;
#pragma unroll
        for (int ai = 0; ai < 2; ++ai)
#pragma unroll
            for (int m = 0; m < 4; ++m) { const int row = row0 + ai * HALF + m * 16; const float rs = row_rstd(ssq, row); bf16_t* rowp = O + (size_t)row * ldc + col0;
#pragma unroll
                for (int bj = 0; bj < 2; ++bj) { f32x4 v0 = acc[ai][bj][m][0] * rs, v1 = acc[ai][bj][m][1] * rs;
                    if (ACT == 1) {
#pragma unroll
                        for (int e = 0; e < 4; ++e) { const float a = fmaxf(v0[e], 0.f), b = fmaxf(v1[e], 0.f); v0[e] = a * a; v1[e] = b * b; } }
                    u32x4 w; w.x = cvt_pk_bf16(v0[0], v0[1]); w.y = cvt_pk_bf16(v0[2], v0[3]); w.z = cvt_pk_bf16(v1[0], v1[1]); w.w = cvt_pk_bf16(v1[2], v1[3]);
                    *(u32x4*)(rowp + bj * HALF) = w; } }
    }
};
struct EpiResid {
    static constexpr bool PERM = true, AFTER_DRAIN = false;
    const float* base; float* out; bf16_t* xb; float* ssq;
    __device__ __forceinline__ void operator()(const f32x4 (&acc)[2][2][4][2], const Unit& u, int wr, int wc, int fr, int fq) const {
        const int row0 = u.pm * BM + wr * 64 + fr; const int col0 = u.pn * BM + wc * 32 + 8 * fq;
#pragma unroll
        for (int ai = 0; ai < 2; ++ai)
#pragma unroll
            for (int m = 0; m < 4; ++m) { const int row = row0 + ai * HALF + m * 16; const size_t off = (size_t)row * 1024 + col0; float s = 0.f;
#pragma unroll
                for (int bj = 0; bj < 2; ++bj) { const f32x4 b0 = *(const f32x4*)(base + off + bj * HALF), b1 = *(const f32x4*)(base + off + bj * HALF + 4);
                    const f32x4 v0 = b0 + acc[ai][bj][m][0], v1 = b1 + acc[ai][bj][m][1];
                    *(f32x4*)(out + off + bj * HALF) = v0; *(f32x4*)(out + off + bj * HALF + 4) = v1;
                    if (xb) { u32x4 w; w.x = cvt_pk_bf16(v0[0], v0[1]); w.y = cvt_pk_bf16(v0[2], v0[3]); w.z = cvt_pk_bf16(v1[0], v1[1]); w.w = cvt_pk_bf16(v1[2], v1[3]); *(u32x4*)(xb + off + bj * HALF) = w; }
                    s += (v0[0] * v0[0] + v0[1] * v0[1]) + (v0[2] * v0[2] + v0[3] * v0[3]) + (v1[0] * v1[0] + v1[1] * v1[1]) + (v1[2] * v1[2] + v1[3] * v1[3]); }
                s += __shfl_xor(s, 16); s += __shfl_xor(s, 32);
                if (fq == 0) ssq[(size_t)row * 16 + u.pn * 4 + wc] = s;
                asm volatile("" ::: "memory"); }
    }
};

template <class Epi, class Sched, bool ALIGN_EPI = false, bool SP2 = false>
__device__ __forceinline__ void gemm_phase(PG8_LAS unsigned char* lds, const Gemm g, const Sched& S, const Epi& E) {
    const int tid = threadIdx.x, wid = __builtin_amdgcn_readfirstlane(tid >> 6), lane = tid & 63, wr = wid >> 2, wc = wid & 3, fr = lane & 15, fq = lane >> 4;
    const int K = g.K, nt = K / BK;
    unsigned voffA[2], voffB[2];
#pragma unroll
    for (int i = 0; i < 2; ++i) { int R, C; stage_rc(tid * 16 + i * 8192, R, C); const int Rb = Epi::PERM ? ((R & ~31) + perm32(R & 31)) : R;
        voffA[i] = (unsigned)(R * K + C) * 2u; voffB[i] = (unsigned)(Rb * K + C) * 2u; }
    const size_t kstep = (size_t)(BK * 2);
    const size_t hstep = (size_t)HALF * K * 2;
    const size_t tstep = 2 * hstep;
    const unsigned ldsw = (unsigned)wid * 1024u;
    const int aoff = lds_byte(wr * 64 + fr, fq * 8), boff = lds_byte(wc * 32 + fr, fq * 8);
#define PG8_SA(b, h) (((b) * 2 + (h)) * HTB)
#define PG8_SB(b, h) ((4 + (b) * 2 + (h)) * HTB)
#define PG8_STAGE(bufoff, gbase, voff) do { _Pragma("unroll") for (int _i = 0; _i < 2; ++_i) \
        __builtin_amdgcn_global_load_lds((const unsigned*)((const char*)(gbase) + (voff)[_i]), (PG8_LAS unsigned*)(lds + (bufoff) + ldsw + _i * 8192), 16, 0, 0); } while (0)
#define PG8_LDA(dst, b, h) do { _Pragma("unroll") for (int m = 0; m < 4; ++m) _Pragma("unroll") for (int k = 0; k < 2; ++k) dst[m][k] = *(const PG8_LAS bf16x8*)(lds + PG8_SA(b, h) + aoff + m * 2048 + k * 1024); } while (0)
#define PG8_LDB(dst, b, h) do { _Pragma("unroll") for (int n = 0; n < 2; ++n) _Pragma("unroll") for (int k = 0; k < 2; ++k) dst[n][k] = *(const PG8_LAS bf16x8*)(lds + PG8_SB(b, h) + boff + n * 2048 + k * 1024); } while (0)
#define PG8_MMA(ai, bj, At, Bt) do { __builtin_amdgcn_s_setprio(1); _Pragma("unroll") for (int m = 0; m < 4; ++m) _Pragma("unroll") for (int n = 0; n < 2; ++n) _Pragma("unroll") for (int k = 0; k < 2; ++k) \
        acc[ai][bj][m][n] = __builtin_amdgcn_mfma_f32_16x16x32_bf16(Bt[n][k], At[m][k], acc[ai][bj][m][n], 0, 0, 0); __builtin_amdgcn_s_setprio(0); } while (0)
#define PG8_WAIT_V(n) asm volatile("s_waitcnt vmcnt(" #n ")" ::: "memory")
#define PG8_WAIT_L(n) asm volatile("s_waitcnt lgkmcnt(" #n ")" ::: "memory")
#define PG8_BAR __builtin_amdgcn_s_barrier()
#define PG8_SCHED __builtin_amdgcn_sched_barrier(0)
    Unit cur, nxt; int ui = 0;
    if (!S.next(0, cur)) return;
    f32x4 acc[2][2][4][2];
#pragma unroll
    for (int a = 0; a < 2; ++a)
#pragma unroll
        for (int b = 0; b < 2; ++b)
#pragma unroll
            for (int m = 0; m < 4; ++m)
#pragma unroll
                for (int n = 0; n < 2; ++n) acc[a][b][m][n] = (f32x4){0.f, 0.f, 0.f, 0.f};
    bf16x8 At[4][2], B0[2][2], B1[2][2];
    const char* cA = (const char*)g.A + (size_t)cur.pm * tstep; const char* cB = (const char*)g.Bt + (size_t)cur.pn * tstep;
    S.a_ready(cur);
    if constexpr (SP2) {
        PG8_STAGE(PG8_SB(0, 0), cB, voffB); PG8_STAGE(PG8_SB(0, 1), cB + hstep, voffB); PG8_STAGE(PG8_SA(0, 0), cA, voffA); PG8_STAGE(PG8_SA(0, 1), cA + hstep, voffA);
        if (wr == 1) PG8_BAR;
        PG8_WAIT_V(2); PG8_BAR;
        PG8_STAGE(PG8_SB(1, 0), cB + kstep, voffB); PG8_STAGE(PG8_SA(1, 0), cA + kstep, voffA); PG8_STAGE(PG8_SB(1, 1), cB + hstep + kstep, voffB);
        PG8_WAIT_V(6); PG8_BAR;
    } else {
        PG8_STAGE(PG8_SB(0, 0), cB, voffB); PG8_STAGE(PG8_SA(0, 0), cA, voffA); PG8_STAGE(PG8_SB(0, 1), cB + hstep, voffB); PG8_STAGE(PG8_SA(0, 1), cA + hstep, voffA);
        if (wr == 1) PG8_BAR;
        PG8_WAIT_V(4); PG8_BAR;
        PG8_STAGE(PG8_SB(1, 0), cB + kstep, voffB); PG8_STAGE(PG8_SA(1, 0), cA + kstep, voffA); PG8_STAGE(PG8_SB(1, 1), cB + hstep + kstep, voffB);
        PG8_WAIT_V(6); PG8_BAR;
    }
    for (;;) {
        const bool has_next = S.next(ui + 1, nxt);
        const char* nA = has_next ? (const char*)g.A + (size_t)nxt.pm * tstep : cA; const char* nB = has_next ? (const char*)g.Bt + (size_t)nxt.pn * tstep : cB;
        for (int t = 0; t < nt; t += 2) {
            const bool last = (t == nt - 2);
            const char* a1 = cA + (size_t)(t + 1) * kstep;
            const char* a2 = last ? nA : cA + (size_t)(t + 2) * kstep; const char* b2 = last ? nB : cB + (size_t)(t + 2) * kstep;
            const char* a3 = a2 + kstep; const char* b3 = b2 + kstep;
            if (last && has_next) S.a_ready(nxt);
            if constexpr (SP2) {
            PG8_LDB(B0, 0, 0); PG8_LDB(B1, 0, 1); PG8_SCHED; PG8_LDA(At, 0, 0); PG8_STAGE(PG8_SA(1, 1), a1 + hstep, voffA);
            PG8_WAIT_V(8); PG8_WAIT_L(0); PG8_BAR; PG8_MMA(0, 0, At, B0); PG8_MMA(0, 1, At, B1); PG8_BAR; PG8_SCHED;
            PG8_LDA(At, 0, 1); PG8_STAGE(PG8_SB(0, 0), b2, voffB); PG8_STAGE(PG8_SB(0, 1), b2 + hstep, voffB); PG8_STAGE(PG8_SA(0, 0), a2, voffA);
            PG8_WAIT_V(8); PG8_WAIT_L(0); PG8_BAR; PG8_MMA(1, 0, At, B0); PG8_MMA(1, 1, At, B1); PG8_BAR; PG8_SCHED;
            PG8_LDB(B0, 1, 0); PG8_LDB(B1, 1, 1); PG8_SCHED; PG8_LDA(At, 1, 0); PG8_STAGE(PG8_SA(0, 1), a2 + hstep, voffA);
            PG8_WAIT_V(8); PG8_WAIT_L(0); PG8_BAR; PG8_MMA(0, 0, At, B0); PG8_MMA(0, 1, At, B1); PG8_BAR; PG8_SCHED;
            PG8_LDA(At, 1, 1); PG8_STAGE(PG8_SB(1, 0), b3, voffB); PG8_STAGE(PG8_SB(1, 1), b3 + hstep, voffB); PG8_STAGE(PG8_SA(1, 0), a3, voffA);
            PG8_WAIT_V(8); PG8_WAIT_L(0); PG8_BAR; PG8_MMA(1, 0, At, B0); PG8_MMA(1, 1, At, B1); PG8_BAR; PG8_SCHED;
            } else {
            PG8_LDB(B0, 0, 0); PG8_SCHED; PG8_LDA(At, 0, 0); PG8_STAGE(PG8_SA(1, 1), a1 + hstep, voffA);
            PG8_WAIT_L(8); PG8_BAR; PG8_WAIT_L(0); PG8_MMA(0, 0, At, B0); PG8_BAR; PG8_SCHED;
            PG8_LDB(B1, 0, 1); PG8_STAGE(PG8_SB(0, 0), b2, voffB);
            PG8_BAR; PG8_WAIT_L(0); PG8_MMA(0, 1, At, B1); PG8_BAR;
            PG8_LDA(At, 0, 1); PG8_STAGE(PG8_SA(0, 0), a2, voffA);
            PG8_BAR; PG8_WAIT_L(0); PG8_MMA(1, 0, At, B0); PG8_BAR; PG8_SCHED;
            PG8_STAGE(PG8_SB(0, 1), b2 + hstep, voffB);
            PG8_WAIT_V(6); PG8_BAR; PG8_MMA(1, 1, At, B1); PG8_BAR;
            PG8_LDB(B0, 1, 0); PG8_SCHED; PG8_LDA(At, 1, 0); PG8_STAGE(PG8_SA(0, 1), a2 + hstep, voffA);
            PG8_WAIT_L(8); PG8_BAR; PG8_WAIT_L(0); PG8_MMA(0, 0, At, B0); PG8_BAR; PG8_SCHED;
            PG8_LDB(B1, 1, 1); PG8_STAGE(PG8_SB(1, 0), b3, voffB);
            PG8_BAR; PG8_WAIT_L(0); PG8_MMA(0, 1, At, B1); PG8_BAR;
            PG8_LDA(At, 1, 1); PG8_STAGE(PG8_SA(1, 0), a3, voffA);
            PG8_BAR; PG8_WAIT_L(0); PG8_MMA(1, 0, At, B0); PG8_BAR; PG8_SCHED;
            PG8_STAGE(PG8_SB(1, 1), b3 + hstep, voffB);
            PG8_WAIT_V(6); PG8_BAR; PG8_MMA(1, 1, At, B1); PG8_BAR;
            }
        }
        if constexpr (ALIGN_EPI) { if (wr == 0) PG8_BAR; }
        if constexpr (!Epi::AFTER_DRAIN) { E(acc, cur, wr, wc, fr, fq); S.done(cur); }
        if (!has_next) break;
#pragma unroll
        for (int a = 0; a < 2; ++a)
#pragma unroll
            for (int b = 0; b < 2; ++b)
#pragma unroll
                for (int m = 0; m < 4; ++m)
#pragma unroll
                    for (int n = 0; n < 2; ++n) acc[a][b][m][n] = (f32x4){0.f, 0.f, 0.f, 0.f};
        cur = nxt; cA = nA; cB = nB; ++ui;
        if constexpr (ALIGN_EPI) { if (wr == 1) PG8_BAR; }
    }
    PG8_WAIT_V(0);
    if constexpr (!ALIGN_EPI) { if (wr == 0) PG8_BAR; }
    PG8_BAR;
    if constexpr (Epi::AFTER_DRAIN) { E.fused(acc, cur, wr, wc, fr, fq, lds, wid, lane); S.done(cur); }
#undef PG8_SA
#undef PG8_SB
#undef PG8_STAGE
#undef PG8_LDA
#undef PG8_LDB
#undef PG8_MMA
#undef PG8_WAIT_V
#undef PG8_WAIT_L
#undef PG8_BAR
#undef PG8_SCHED
}
}

#include <hip/hip_cooperative_groups.h>
namespace cg = cooperative_groups;

#define LAS __attribute__((address_space(3)))
typedef unsigned short bf16;
typedef unsigned v4u __attribute__((ext_vector_type(4)));
typedef unsigned v2u __attribute__((ext_vector_type(2)));
typedef float f32x4 __attribute__((ext_vector_type(4)));
typedef short bf16x8 __attribute__((ext_vector_type(8)));
typedef short s16x4 __attribute__((ext_vector_type(4)));

constexpr int NWAVES = 8, NT = NWAVES * 64;
constexpr int BATCH = 4, SEQ = 4096, D = 1024, M = BATCH * SEQ, FF = 4096, NH = 16, HD = 64, GW = 64, ROWS = 64, KH = 8, WW = 16;
constexpr size_t MiB = 1u << 20;
constexpr size_t WS_BAR = 0;
constexpr int BARST_OFF = 151552;
constexpr size_t WS_SSQ = 1 * MiB;
constexpr size_t WS_WIN = 4 * MiB, WS_WOUT = 10 * MiB, WS_WQKV = 12 * MiB, WS_WO = 18 * MiB, WS_WUP0 = 20 * MiB, WS_WUP1 = 28 * MiB, WS_WDN0 = 36 * MiB, WS_WDN1 = 44 * MiB;
constexpr size_t WS_XB = 52 * MiB;
constexpr size_t WS_U = 84 * MiB;
constexpr size_t WS_Y = 180 * MiB;
constexpr size_t WS_A = 84 * MiB;
constexpr size_t WS_END = 212 * MiB;
constexpr int LDS_BYTES = 152576;

__device__ __forceinline__ unsigned f2bf(float f) { unsigned u = __builtin_bit_cast(unsigned, f); return (u + 0x7fffu + ((u >> 16) & 1u)) >> 16; }
__device__ __forceinline__ unsigned pk2(float lo, float hi) { return f2bf(lo) | (f2bf(hi) << 16); }
__device__ __forceinline__ float bf_lo(unsigned w) { return __builtin_bit_cast(float, w << 16); }
__device__ __forceinline__ float bf_hi(unsigned w) { return __builtin_bit_cast(float, w & 0xffff0000u); }
#define LDS_WAIT() asm volatile("s_waitcnt lgkmcnt(0)" ::: "memory")

__device__ __forceinline__ float wave_sum(float v) {
#pragma unroll
    for (int o = 1; o < 64; o <<= 1) v += __shfl_xor(v, o);
    return v;
}

__device__ __forceinline__ void p0_transpose_item(const float* W, int K, int N, bf16* WT, const float* g, LAS float* scr, int item, int lane) {
    const int nblk = N / 32, kb = item / nblk, nb = item % nblk, k0 = 64 * kb, n0 = 32 * nb;
#pragma unroll 8
    for (int i = 0; i < 32; ++i) { const int kk = 2 * i + (lane >> 5); float w = W[(size_t)(k0 + kk) * N + n0 + (lane & 31)]; if (g) w *= g[k0 + kk]; scr[kk * 33 + (lane & 31)] = w; }
    LDS_WAIT(); asm volatile("" ::: "memory");
    const int c = lane & 7;
#pragma unroll
    for (int j = 0; j < 4; ++j) { const int n = (lane >> 3) + 8 * j; const LAS float* s = scr + (8 * c) * 33 + n;
        v4u o; o.x = pk2(s[0 * 33], s[1 * 33]); o.y = pk2(s[2 * 33], s[3 * 33]); o.z = pk2(s[4 * 33], s[5 * 33]); o.w = pk2(s[6 * 33], s[7 * 33]);
        *(v4u*)(WT + (size_t)(n0 + n) * K + k0 + 8 * c) = o; }
    LDS_WAIT(); asm volatile("" ::: "memory");
}

#define XB_TMO      128
#define XB_XCNT(j)  (256  + 64 * (j))
#define XB_XSUB(j)  (1280 + 64 * (j))
#define XB_XGEN(j)  (2304 + 64 * (j))
#define XB_TOP      3328
#define XB_TOPGEN   3392
#define XCD_BAR_WORDS 3456
#define XB_SPIN_CAP (1u << 18)

__device__ __forceinline__ unsigned xb_ld(unsigned* p)              { return __hip_atomic_load(p, __ATOMIC_RELAXED, __HIP_MEMORY_SCOPE_AGENT); }
__device__ __forceinline__ unsigned xb_add(unsigned* p, unsigned v) { return __hip_atomic_fetch_add(p, v, __ATOMIC_RELAXED, __HIP_MEMORY_SCOPE_AGENT); }
__device__ __forceinline__ unsigned xb_xcc_id() { return (unsigned)__builtin_amdgcn_s_getreg((3 << 11) | 20) & 0xFu; }
#define XB_SPIN(cond, bar) do { unsigned _sp = 0; while (cond) { __builtin_amdgcn_s_sleep(1); \
    if ((++_sp & 255u) == 0u) { if (xb_ld(&(bar)[XB_TMO])) break; if (_sp > XB_SPIN_CAP) { atomicAdd(&(bar)[XB_TMO], 1u); break; } } } } while (0)

struct XcdBarrier {
    unsigned* bar; unsigned x;
    volatile LAS unsigned* st;
};

__device__ __forceinline__ XcdBarrier xcd_barrier_post(unsigned* bar, volatile LAS unsigned* st) {
    XcdBarrier b; b.bar = bar; b.x = xb_xcc_id(); b.st = st;
    if (threadIdx.x == 0) (void)xb_add(&bar[XB_XCNT(b.x)], 1u);
    return b;
}
__device__ __forceinline__ void xcd_barrier_complete(unsigned* bar, unsigned x, unsigned& nloc, unsigned& nx) {
    const unsigned G = gridDim.x * gridDim.y * gridDim.z;
    unsigned sum, cnt, mine, sp = 0u;
    for (;;) {
        sum = 0u; cnt = 0u; mine = 0u;
#pragma unroll
        for (unsigned j = 0; j < 16; ++j) { const unsigned c = xb_ld(&bar[XB_XCNT(j)]); sum += c; cnt += (c > 0u) ? 1u : 0u; mine = (j == x) ? c : mine; }
        if (sum == G) break;
        __builtin_amdgcn_s_sleep(1);
        if ((++sp & 255u) == 0u) { if (xb_ld(&bar[XB_TMO])) break; if (sp > XB_SPIN_CAP) { atomicAdd(&bar[XB_TMO], 1u); break; } }
    }
    nloc = mine > 0u ? mine : 1u; nx = cnt > 0u ? cnt : 1u;
}

__device__ __forceinline__ void xcd_barrier(const XcdBarrier& b) {
    asm volatile("s_waitcnt vmcnt(0)" ::: "memory");
    __syncthreads();
    if (threadIdx.x == 0) {
        unsigned* bar = b.bar;
        __builtin_amdgcn_s_waitcnt(0);
        unsigned nloc = b.st[0], nx = b.st[1];
        if (nloc == 0u) { xcd_barrier_complete(bar, b.x, nloc, nx); b.st[0] = nloc; b.st[1] = nx; }
        const unsigned old = xb_add(&bar[XB_XSUB(b.x)], 1u);
        const unsigned gen = old / nloc;
        if (old + 1u == (gen + 1u) * nloc) {
            __builtin_amdgcn_fence(__ATOMIC_RELEASE, "agent");
            asm volatile("s_waitcnt vmcnt(0)" ::: "memory");
            const unsigned og = xb_add(&bar[XB_TOP], 1u);
            const unsigned tg = og / nx;
            if (og + 1u == (tg + 1u) * nx) xb_add(&bar[XB_TOPGEN], 1u);
            else XB_SPIN(xb_ld(&bar[XB_TOPGEN]) == tg, bar);
            __builtin_amdgcn_fence(__ATOMIC_ACQUIRE, "agent");
            xb_add(&bar[XB_XGEN(b.x)], 1u);
            asm volatile("s_waitcnt vmcnt(0)" ::: "memory");
        } else {
            XB_SPIN(xb_ld(&bar[XB_XGEN(b.x)]) == gen, bar);
            __builtin_amdgcn_fence(__ATOMIC_ACQUIRE, "agent");
            asm volatile("s_waitcnt vmcnt(0)" ::: "memory");
        }
    }
    __syncthreads();
}

struct Args {
    const float* x; const float* norm_mix; const float* conv_w_in; const float* conv_w; const float* conv_w_out; const float* attn_w_qkv; const float* attn_rpb; const float* attn_w_o;
    const float* norm_mlp; const float* mlp_w_up; const float* mlp_w_down; const float* norm_final; float* out; unsigned char* ws;
};

__device__ __forceinline__ void p0_prologue(const Args& a, LAS unsigned char* lds, int gw, int NGW, int wave, int lane) {
    LAS float* scr = (LAS float*)(lds + wave * 16384);
    unsigned char* ws = a.ws;
    constexpr int I_IN = 16 * 96, I_SQ = 16 * 32, I_UP = 16 * 128, I_DN = 64 * 32;
    constexpr int NITEMS = 2 * I_IN + 2 * I_SQ + 2 * I_UP + 2 * I_DN;
    for (int it = gw; it < NITEMS; it += NGW) {
        int r = it;
        if (r < I_IN) { p0_transpose_item(a.conv_w_in, D, 3 * D, (bf16*)(ws + WS_WIN), a.norm_mix, scr, r, lane); continue; } r -= I_IN;
        if (r < I_IN) { p0_transpose_item(a.attn_w_qkv, D, 3 * D, (bf16*)(ws + WS_WQKV), a.norm_mix + D, scr, r, lane); continue; } r -= I_IN;
        if (r < I_SQ) { p0_transpose_item(a.conv_w_out, D, D, (bf16*)(ws + WS_WOUT), nullptr, scr, r, lane); continue; } r -= I_SQ;
        if (r < I_SQ) { p0_transpose_item(a.attn_w_o, D, D, (bf16*)(ws + WS_WO), nullptr, scr, r, lane); continue; } r -= I_SQ;
        if (r < I_UP) { p0_transpose_item(a.mlp_w_up, D, FF, (bf16*)(ws + WS_WUP0), a.norm_mlp, scr, r, lane); continue; } r -= I_UP;
        if (r < I_UP) { p0_transpose_item(a.mlp_w_up + (size_t)D * FF, D, FF, (bf16*)(ws + WS_WUP1), a.norm_mlp + D, scr, r, lane); continue; } r -= I_UP;
        if (r < I_DN) { p0_transpose_item(a.mlp_w_down, FF, D, (bf16*)(ws + WS_WDN0), nullptr, scr, r, lane); continue; } r -= I_DN;
        p0_transpose_item(a.mlp_w_down + (size_t)FF * D, FF, D, (bf16*)(ws + WS_WDN1), nullptr, scr, r, lane);
    }
    bf16* XB = (bf16*)(ws + WS_XB); float* SSQ = (float*)(ws + WS_SSQ);
    for (int m = gw; m < M; m += NGW) {
        const f32x4* xr = (const f32x4*)(a.x + (size_t)m * D) + lane; f32x4 v[4]; float s = 0.f;
#pragma unroll
        for (int j = 0; j < 4; ++j) { v[j] = xr[64 * j]; s += (v[j].x * v[j].x + v[j].y * v[j].y) + (v[j].z * v[j].z + v[j].w * v[j].w); }
        s = wave_sum(s);
        v2u* o8 = (v2u*)(XB + (size_t)m * D) + lane;
#pragma unroll
        for (int j = 0; j < 4; ++j) { v2u o; o.x = pk2(v[j].x, v[j].y); o.y = pk2(v[j].z, v[j].w); o8[64 * j] = o; }
        if (lane < 16) SSQ[(size_t)m * 16 + lane] = (lane == 0) ? s : 0.f;
    }
}

__device__ __forceinline__ void conv_phase(const Args& a, int gw, int NGW, int lane) {
    const bf16* U = (const bf16*)(a.ws + WS_U); bf16* Y = (bf16*)(a.ws + WS_Y);
    constexpr int TCH = 16, NTASK = (M / TCH) * 2;
    for (int task = gw; task < NTASK; task += NGW) {
        const int ch = task >> 1, hf = task & 1, t0 = ch * TCH, d0 = hf * 512 + lane * 8;
        float w0[8], w1[8], w2[8];
#pragma unroll
        for (int e = 0; e < 8; ++e) { w0[e] = a.conv_w[d0 + e]; w1[e] = a.conv_w[D + d0 + e]; w2[e] = a.conv_w[2 * D + d0 + e]; }
        float zp[8], zc[8], zn[8];
        auto loadz = [&](int t, float* z) {
            const v4u c = *(const v4u*)(U + (size_t)t * (3 * D) + D + d0), v = *(const v4u*)(U + (size_t)t * (3 * D) + 2 * D + d0);
            z[0] = bf_lo(c.x) * bf_lo(v.x); z[1] = bf_hi(c.x) * bf_hi(v.x); z[2] = bf_lo(c.y) * bf_lo(v.y); z[3] = bf_hi(c.y) * bf_hi(v.y);
            z[4] = bf_lo(c.z) * bf_lo(v.z); z[5] = bf_hi(c.z) * bf_hi(v.z); z[6] = bf_lo(c.w) * bf_lo(v.w); z[7] = bf_hi(c.w) * bf_hi(v.w); };
        if ((t0 & (SEQ - 1)) == 0) {
#pragma unroll
            for (int e = 0; e < 8; ++e) zp[e] = 0.f; } else loadz(t0 - 1, zp);
        loadz(t0, zc);
        for (int i = 0; i < TCH; ++i) {
            const int t = t0 + i;
            if (((t + 1) & (SEQ - 1)) == 0) {
#pragma unroll
                for (int e = 0; e < 8; ++e) zn[e] = 0.f; } else loadz(t + 1, zn);
            const v4u bb = *(const v4u*)(U + (size_t)t * (3 * D) + d0);
            float bv[8] = {bf_lo(bb.x), bf_hi(bb.x), bf_lo(bb.y), bf_hi(bb.y), bf_lo(bb.z), bf_hi(bb.z), bf_lo(bb.w), bf_hi(bb.w)};
            float y[8];
#pragma unroll
            for (int e = 0; e < 8; ++e) y[e] = bv[e] * (w0[e] * zp[e] + w1[e] * zc[e] + w2[e] * zn[e]);
            v4u o; o.x = pk2(y[0], y[1]); o.y = pk2(y[2], y[3]); o.z = pk2(y[4], y[5]); o.w = pk2(y[6], y[7]);
            *(v4u*)(Y + (size_t)t * D + d0) = o;
#pragma unroll
            for (int e = 0; e < 8; ++e) { zp[e] = zc[e]; zc[e] = zn[e]; }
        }
    }
}

constexpr int AT_K = 0, AT_V = 73728, AT_B = 147456;
__device__ __forceinline__ int swz(int col) { return ((col >> 1) & 1) | (((col >> 3) & 3) << 1); }
__device__ __forceinline__ int rstart(int r) { return min(max(r - KH / 2, 0), ROWS - KH); }
__device__ __forceinline__ void attn_phase(const Args& a, LAS unsigned char* lds, int G, int bid, int tid) {
    const bf16* QKV = (const bf16*)(a.ws + WS_U); bf16* Y = (bf16*)(a.ws + WS_Y);
    LAS unsigned char* Kl = lds + AT_K; LAS unsigned char* Vl = lds + AT_V; LAS float* Bl = (LAS float*)(lds + AT_B);
    const int wave = __builtin_amdgcn_readfirstlane(tid >> 6), lane = tid & 63, g = lane >> 4, qi = lane & 15;
    const int j = wave & 3, wr = wave >> 2;
    const int c0 = (j == 0) ? 0 : (j == 1) ? 8 : (j == 2) ? 24 : 32;
    const int c = 16 * j + qi, cs = min(max(c - WW / 2, 0), GW - WW);
    int baddr[8];
#pragma unroll
    for (int T = 0; T < 2; ++T)
#pragma unroll
        for (int e = 0; e < 4; ++e) { const int kcol = c0 + 8 * g + 4 * T + e; const bool ok = (kcol >= cs) && (kcol < cs + WW); baddr[T * 4 + e] = AT_B + (ok ? (kcol - c + 15) : 31) * 4; }
    const int lcol = tid >> 3, lchunk = tid & 7, loff = (lcol << 7) + ((lchunk ^ swz(lcol)) << 4);
    const int kcolA = c0 + 8 * (qi >> 2) + (qi & 3);
    const int vq = qi >> 2, vp = qi & 3, vcol = c0 + 8 * g + vq, vsw = swz(vcol);
    const float SC = 0.125f * 1.4426950408889634f;
    for (int st = bid; st < BATCH * NH * 4; st += G) {
        const int b = st >> 6, h = (st >> 2) & 15, seg = st & 3, r0 = seg * 16;
        const bf16* kvsrc = QKV + ((size_t)b * SEQ + lcol) * (3 * D) + D + h * HD + lchunk * 8;
        __syncthreads();
        { const int row = tid >> 5, col = tid & 31; Bl[tid] = (row < 15 && col < 31) ? a.attn_rpb[h * 465 + row * 31 + col] * 1.4426950408889634f : -INFINITY; }
        int hi = rstart(r0 + 1) + 7;
        for (int row = rstart(r0); row <= hi; ++row) { const bf16* p = kvsrc + (size_t)row * (GW * 3 * D); const v4u k = *(const v4u*)p, v = *(const v4u*)(p + D);
            const int off = (row % 9) * 8192 + loff; *(LAS v4u*)(Kl + off) = k; *(LAS v4u*)(Vl + off) = v; }
        v4u pk0, pv0, pk1, pv1; int npre = 0;
        pk0 = pv0 = pk1 = pv1 = (v4u){0u, 0u, 0u, 0u};
        bf16x8 q0, q1;
        { const size_t qtok = (size_t)b * SEQ + (r0 + wr) * GW + c; q0 = *(const bf16x8*)(QKV + qtok * (3 * D) + h * HD + g * 8); q1 = *(const bf16x8*)(QKV + qtok * (3 * D) + h * HD + 32 + g * 8); }
        for (int p = 0; p < 8; ++p) {
            const int r = r0 + 2 * p;
            if (p > 0) {
                __syncthreads();
                if (npre > 0) { const int off = ((hi + 1) % 9) * 8192 + loff; *(LAS v4u*)(Kl + off) = pk0; *(LAS v4u*)(Vl + off) = pv0; }
                if (npre > 1) { const int off = ((hi + 2) % 9) * 8192 + loff; *(LAS v4u*)(Kl + off) = pk1; *(LAS v4u*)(Vl + off) = pv1; }
                hi += npre;
            }
            __syncthreads();
            bf16x8 q0n = q0, q1n = q1;
            if (p < 7) {
                npre = rstart(r + 3) + 7 - hi;
                if (npre > 0) { const bf16* pp = kvsrc + (size_t)(hi + 1) * (GW * 3 * D); pk0 = *(const v4u*)pp; pv0 = *(const v4u*)(pp + D); }
                if (npre > 1) { const bf16* pp = kvsrc + (size_t)(hi + 2) * (GW * 3 * D); pk1 = *(const v4u*)pp; pv1 = *(const v4u*)(pp + D); }
                const size_t qtok = (size_t)b * SEQ + (r + 2 + wr) * GW + c; q0n = *(const bf16x8*)(QKV + qtok * (3 * D) + h * HD + g * 8); q1n = *(const bf16x8*)(QKV + qtok * (3 * D) + h * HD + 32 + g * 8);
            }
            {
                const int rr = r + wr, s = rstart(rr); const int sl = s % 9;
                const int roffb = (s - rr + 7) * 128;
                f32x4 sc[8][2];
                float mx = -INFINITY;
#pragma unroll
                for (int i = 0; i < 8; ++i) {
                    const int slot = (sl + i >= 9) ? sl + i - 9 : sl + i;
#pragma unroll
                    for (int T = 0; T < 2; ++T) {
                        const int kc = kcolA + 4 * T; const int base = slot * 8192 + (kc << 7), sw = swz(kc);
                        const bf16x8 k0 = *(const LAS bf16x8*)(Kl + base + ((g ^ sw) << 4)), k1 = *(const LAS bf16x8*)(Kl + base + (((4 + g) ^ sw) << 4));
                        f32x4 acc = (f32x4){0.f, 0.f, 0.f, 0.f};
                        acc = __builtin_amdgcn_mfma_f32_16x16x32_bf16(k0, q0, acc, 0, 0, 0);
                        acc = __builtin_amdgcn_mfma_f32_16x16x32_bf16(k1, q1, acc, 0, 0, 0);
#pragma unroll
                        for (int e = 0; e < 4; ++e) { const float bias = *(const LAS float*)(lds + baddr[T * 4 + e] + roffb + i * 128); const float v = acc[e] * SC + bias; acc[e] = v; mx = fmaxf(mx, v); }
                        sc[i][T] = acc;
                    }
                }
                mx = fmaxf(mx, __shfl_xor(mx, 16)); mx = fmaxf(mx, __shfl_xor(mx, 32));
                float sum = 0.f;
#pragma unroll
                for (int i = 0; i < 8; ++i)
#pragma unroll
                    for (int T = 0; T < 2; ++T)
#pragma unroll
                        for (int e = 0; e < 4; ++e) { const float pe = __builtin_amdgcn_exp2f(sc[i][T][e] - mx); sc[i][T][e] = pe; sum += pe; }
                sum += __shfl_xor(sum, 16); sum += __shfl_xor(sum, 32);
                f32x4 o[4];
#pragma unroll
                for (int dt = 0; dt < 4; ++dt) o[dt] = (f32x4){0.f, 0.f, 0.f, 0.f};
#pragma unroll
                for (int i = 0; i < 8; ++i) {
                    const int slot = (sl + i >= 9) ? sl + i - 9 : sl + i;
                    v4u pw; pw.x = pg8::cvt_pk_bf16(sc[i][0][0], sc[i][0][1]); pw.y = pg8::cvt_pk_bf16(sc[i][0][2], sc[i][0][3]); pw.z = pg8::cvt_pk_bf16(sc[i][1][0], sc[i][1][1]); pw.w = pg8::cvt_pk_bf16(sc[i][1][2], sc[i][1][3]);
                    const bf16x8 pf = __builtin_bit_cast(bf16x8, pw);
                    const int vbase = slot * 8192 + (vcol << 7) + (vp & 1) * 8;
#pragma unroll
                    for (int dt = 0; dt < 4; ++dt) {
                        const int ch = ((dt * 2 + (vp >> 1)) ^ vsw) << 4;
                        const s16x4 lo = __builtin_bit_cast(s16x4, __builtin_amdgcn_ds_read_tr16_b64_v4i16((LAS s16x4*)(Vl + vbase + ch)));
                        const s16x4 hi4 = __builtin_bit_cast(s16x4, __builtin_amdgcn_ds_read_tr16_b64_v4i16((LAS s16x4*)(Vl + vbase + ch + 512)));
                        bf16x8 vf; vf[0] = lo[0]; vf[1] = lo[1]; vf[2] = lo[2]; vf[3] = lo[3]; vf[4] = hi4[0]; vf[5] = hi4[1]; vf[6] = hi4[2]; vf[7] = hi4[3];
                        o[dt] = __builtin_amdgcn_mfma_f32_16x16x32_bf16(vf, pf, o[dt], 0, 0, 0);
                    }
                }
                const float inv = 1.0f / sum;
                bf16* yp = Y + ((size_t)b * SEQ + rr * GW + c) * D + h * HD + 4 * g;
#pragma unroll
                for (int dt = 0; dt < 4; ++dt) { v2u w; w.x = pg8::cvt_pk_bf16(o[dt][0] * inv, o[dt][1] * inv); w.y = pg8::cvt_pk_bf16(o[dt][2] * inv, o[dt][3] * inv); *(v2u*)(yp + dt * 16) = w; }
            }
            q0 = q0n; q1 = q1n;
        }
    }
}

__device__ __forceinline__ void final_norm(const Args& a, int gw, int NGW, int lane) {
    const float* SSQ = (const float*)(a.ws + WS_SSQ);
    f32x4 gv[4];
#pragma unroll
    for (int j = 0; j < 4; ++j) gv[j] = ((const f32x4*)a.norm_final)[lane + 64 * j];
    for (int m = gw; m < M; m += NGW) {
        const float rs = pg8::row_rstd(SSQ, m);
        f32x4* xr = (f32x4*)(a.out + (size_t)m * D) + lane;
#pragma unroll
        for (int j = 0; j < 4; ++j) { f32x4 v = xr[64 * j]; v = v * rs * gv[j]; xr[64 * j] = v; }
    }
}

__global__ void __launch_bounds__(NT) fwd_megakernel(Args a) {
    extern __shared__ __attribute__((aligned(16))) unsigned char lds_raw[];
    LAS unsigned char* lds = (LAS unsigned char*)lds_raw;
    cg::grid_group grid = cg::this_grid();
    const int tid = threadIdx.x, lane = tid & 63, wave = __builtin_amdgcn_readfirstlane(tid >> 6);
    const int G = gridDim.x, bid = blockIdx.x, gw = bid * NWAVES + wave, NGW = G * NWAVES;
    unsigned char* ws = a.ws;
    bf16* XB = (bf16*)(ws + WS_XB); bf16* U = (bf16*)(ws + WS_U); bf16* Y = (bf16*)(ws + WS_Y); bf16* A = (bf16*)(ws + WS_A); float* SSQ = (float*)(ws + WS_SSQ);

    if (bid == 0) for (int i = tid; i < XCD_BAR_WORDS; i += NT) __hip_atomic_store((unsigned*)(ws + WS_BAR) + i, 0u, __ATOMIC_RELAXED, __HIP_MEMORY_SCOPE_AGENT);
    if (tid < 2) ((volatile LAS unsigned*)(lds + BARST_OFF))[tid] = 0u;
    p0_prologue(a, lds, gw, NGW, wave, lane);
    grid.sync();
    const XcdBarrier bar = xcd_barrier_post((unsigned*)(ws + WS_BAR), (volatile LAS unsigned*)(lds + BARST_OFF));
    { pg8::Gemm g{XB, (const bf16*)(ws + WS_WIN), M, 3 * D, D}; pg8::StaticOrder S; S.init(M, 3 * D, G, bid); pg8::EpiScale<0> E{U, 3 * D, SSQ};
      pg8::gemm_phase<pg8::EpiScale<0>, pg8::StaticOrder, true, true>(lds, g, S, E); }
    xcd_barrier(bar);
    conv_phase(a, gw, NGW, lane);
    xcd_barrier(bar);
    { pg8::Gemm g{Y, (const bf16*)(ws + WS_WOUT), M, D, D}; pg8::StaticOrder S; S.init(M, D, G, bid); pg8::EpiResid E{a.x, a.out, XB, SSQ};
      pg8::gemm_phase<pg8::EpiResid, pg8::StaticOrder, true, true>(lds, g, S, E); }
    xcd_barrier(bar);
    { pg8::Gemm g{XB, (const bf16*)(ws + WS_WUP0), M, FF, D}; pg8::StaticOrder S; S.init(M, FF, G, bid); pg8::EpiScale<1> E{A, FF, SSQ};
      pg8::gemm_phase<pg8::EpiScale<1>, pg8::StaticOrder, true, true>(lds, g, S, E); }
    xcd_barrier(bar);
    { pg8::Gemm g{A, (const bf16*)(ws + WS_WDN0), M, D, FF}; pg8::StaticOrder S; S.init(M, D, G, bid); pg8::EpiResid E{a.out, a.out, XB, SSQ};
      pg8::gemm_phase<pg8::EpiResid, pg8::StaticOrder, true, true>(lds, g, S, E); }
    xcd_barrier(bar);
    { pg8::Gemm g{XB, (const bf16*)(ws + WS_WQKV), M, 3 * D, D}; pg8::StaticOrder S; S.init(M, 3 * D, G, bid); pg8::EpiScale<0> E{U, 3 * D, SSQ};
      pg8::gemm_phase<pg8::EpiScale<0>, pg8::StaticOrder, true, true>(lds, g, S, E); }
    xcd_barrier(bar);
    attn_phase(a, lds, G, bid, tid);
    xcd_barrier(bar);
    { pg8::Gemm g{Y, (const bf16*)(ws + WS_WO), M, D, D}; pg8::StaticOrder S; S.init(M, D, G, bid); pg8::EpiResid E{a.out, a.out, XB, SSQ};
      pg8::gemm_phase<pg8::EpiResid, pg8::StaticOrder, true, true>(lds, g, S, E); }
    xcd_barrier(bar);
    { pg8::Gemm g{XB, (const bf16*)(ws + WS_WUP1), M, FF, D}; pg8::StaticOrder S; S.init(M, FF, G, bid); pg8::EpiScale<1> E{A, FF, SSQ};
      pg8::gemm_phase<pg8::EpiScale<1>, pg8::StaticOrder, true, true>(lds, g, S, E); }
    xcd_barrier(bar);
    { pg8::Gemm g{A, (const bf16*)(ws + WS_WDN1), M, D, FF}; pg8::StaticOrder S; S.init(M, D, G, bid); pg8::EpiResid E{a.out, a.out, nullptr, SSQ};
      pg8::gemm_phase<pg8::EpiResid, pg8::StaticOrder, true, true>(lds, g, S, E); }
    xcd_barrier(bar);
    final_norm(a, gw, NGW, lane);
}

extern "C" void kernel_launch(void* const* d_in, const int* in_sizes, int n_in, void* d_out, int out_size, void* d_ws, size_t ws_size, hipStream_t stream) {
    static int grid = 0;
    if (grid == 0) {
        if (n_in != 12 || in_sizes[0] != M * D || out_size != M * D || ws_size < WS_END) { fprintf(stderr, "kernel_launch: unexpected shapes (n_in %d, in0 %d, out %d, ws %zu)\n", n_in, n_in > 0 ? in_sizes[0] : -1, out_size, ws_size); grid = -1; return; }
        int dev = 0, cus = 0, per_cu = 0;
        (void)hipGetDevice(&dev); (void)hipDeviceGetAttribute(&cus, hipDeviceAttributeMultiprocessorCount, dev);
        (void)hipFuncSetAttribute((const void*)fwd_megakernel, hipFuncAttributeMaxDynamicSharedMemorySize, LDS_BYTES);
        (void)hipOccupancyMaxActiveBlocksPerMultiprocessor(&per_cu, (const void*)fwd_megakernel, NT, LDS_BYTES);
        if (per_cu < 1) { fprintf(stderr, "kernel_launch: occupancy query says %d blocks per CU\n", per_cu); per_cu = 1; }
        (void)hipGetLastError();
        grid = cus * per_cu;
    }
    if (grid < 0) return;
    Args a{};
    a.x = (const float*)d_in[0]; a.norm_mix = (const float*)d_in[1]; a.conv_w_in = (const float*)d_in[2]; a.conv_w = (const float*)d_in[3]; a.conv_w_out = (const float*)d_in[4];
    a.attn_w_qkv = (const float*)d_in[5]; a.attn_rpb = (const float*)d_in[6]; a.attn_w_o = (const float*)d_in[7]; a.norm_mlp = (const float*)d_in[8]; a.mlp_w_up = (const float*)d_in[9];
    a.mlp_w_down = (const float*)d_in[10]; a.norm_final = (const float*)d_in[11]; a.out = (float*)d_out; a.ws = (unsigned char*)d_ws;
    void* args[] = {&a};
    hipError_t e = hipLaunchCooperativeKernel((const void*)fwd_megakernel, dim3(grid), dim3(NT), args, LDS_BYTES, stream);
    if (e != hipSuccess) fprintf(stderr, "kernel_launch: cooperative launch failed: %s (grid %d)\n", hipGetErrorString(e), grid);
}
```

```cpp
#include <hip/hip_runtime.h>
#include <cstdio>
#include <cstdint>
namespace pg8 {
#define PG8_LAS __attribute__((address_space(3)))
typedef unsigned short bf16_t;
typedef short bf16x8 __attribute__((ext_vector_type(8)));
typedef float f32x4 __attribute__((ext_vector_type(4)));
typedef unsigned u32x4 __attribute__((ext_vector_type(4)));
constexpr int BM = 256, BK = 64, HALF = 128, HTB = HALF * BK * 2  , STAGE_BYTES = 8 * HTB, NXCD = 8, WGM = 8;

__host__ __device__ __forceinline__ int lds_byte(int r, int c) { const int st = (r >> 4) * 2 + (c >> 5), rr = r & 15, cc = c & 31, ob = rr * 64 + cc * 2; return st * 1024 + (ob ^ (((ob >> 9) & 1) << 5)); }
__host__ __device__ __forceinline__ void stage_rc(int b, int& R, int& C) { const int st = b / 1024, sb = b % 1024, swz = sb ^ (((sb >> 9) & 1) << 5); R = (st >> 1) * 16 + swz / 64; C = (st & 1) * 32 + (swz % 64) / 2; }
__host__ __device__ __forceinline__ int perm32(int rho) { const int n = rho >> 4, i = rho & 15; return 8 * (i >> 2) + 4 * n + (i & 3); }

struct Unit { int pm, pn; };
struct Gemm { const bf16_t* A; const bf16_t* Bt; int M, N, K; };

struct StaticOrder {
    int nM, nN, nwg, G, c;
    __host__ __device__ void init(int M, int N, int G_, int c_) { nM = M / BM; nN = N / BM; nwg = nM * nN; G = G_; c = c_; }
    __host__ __device__ bool next(int i, Unit& u) const {
        const long L = (long)i * G + c; if (L >= nwg) return false;
        int wgid = (int)L; { const int q = nwg / NXCD, r = nwg % NXCD, xcd = wgid % NXCD, off = wgid / NXCD; wgid = (xcd < r ? xcd * (q + 1) : r * (q + 1) + (xcd - r) * q) + off; }
        const int nig = WGM * nN, gid = wgid / nig, fm = gid * WGM, gsz = (nM - fm) < WGM ? (nM - fm) : WGM;
        u.pm = fm + ((wgid % nig) % gsz); u.pn = (wgid % nig) / gsz; return true;
    }
    __device__ __forceinline__ void a_ready(const Unit&) const {}
    __device__ __forceinline__ void done(const Unit&) const {}
};

__device__ __forceinline__ unsigned cvt_pk_bf16(float lo, float hi) { unsigned r; asm volatile("v_cvt_pk_bf16_f32 %0, %1, %2" : "=v"(r) : "v"(lo), "v"(hi)); return r; }
typedef float f32x2 __attribute__((ext_vector_type(2)));

__device__ __forceinline__ float row_rstd(const float* ssq, int row) {
    const f32x4* p = (const f32x4*)(ssq + (size_t)row * 16);
    const f32x4 a = p[0], b = p[1], c = p[2], d = p[3];
    const f32x4 s = (a + b) + (c + d);
    const float t = (s[0] + s[1]) + (s[2] + s[3]);
    return 1.0f / sqrtf(t * (1.0f / 1024.0f) + 1e-6f);
}
template <int ACT> struct EpiScale {
    static constexpr bool PERM = true, AFTER_DRAIN = false;
    bf16_t* O; int ldc; const float* ssq;
    __device__ __forceinline__ void operator()(const f32x4 (&acc)[2][2][4][2], const Unit& u, int wr, int wc, int fr, int fq) const {
        const int row0 = u.pm * BM + wr * 64 + fr; const int col0 = u.pn * BM + wc * 32 + 8 * fq;
#pragma unroll
        for (int ai = 0; ai < 2; ++ai)
#pragma unroll
            for (int m = 0; m < 4; ++m) { const int row = row0 + ai * HALF + m * 16; const float rs = row_rstd(ssq, row); bf16_t* rowp = O + (size_t)row * ldc + col0;
#pragma unroll
                for (int bj = 0; bj < 2; ++bj) { f32x4 v0 = acc[ai][bj][m][0] * rs, v1 = acc[ai][bj][m][1] * rs;
                    if (ACT == 1) {
#pragma unroll
                        for (int e = 0; e < 4; ++e) { const float a = fmaxf(v0[e], 0.f), b = fmaxf(v1[e], 0.f); v0[e] = a * a; v1[e] = b * b; } }
                    u32x4 w; w.x = cvt_pk_bf16(v0[0], v0[1]); w.y = cvt_pk_bf16(v0[2], v0[3]); w.z = cvt_pk_bf16(v1[0], v1[1]); w.w = cvt_pk_bf16(v1[2], v1[3]);
                    *(u32x4*)(rowp + bj * HALF) = w; } }
    }
};
struct EpiResid {
    static constexpr bool PERM = true, AFTER_DRAIN = false;
    const float* basef; const bf16_t* baseb; float* outf; bf16_t* outb; float* ssq;
    __device__ __forceinline__ void operator()(const f32x4 (&acc)[2][2][4][2], const Unit& u, int wr, int wc, int fr, int fq) const {
        const int row0 = u.pm * BM + wr * 64 + fr; const int col0 = u.pn * BM + wc * 32 + 8 * fq;
#pragma unroll
        for (int ai = 0; ai < 2; ++ai)
#pragma unroll
            for (int m = 0; m < 4; ++m) { const int row = row0 + ai * HALF + m * 16; const size_t off = (size_t)row * 1024 + col0; float s = 0.f;
#pragma unroll
                for (int bj = 0; bj < 2; ++bj) { f32x4 b0, b1;
                    if (basef) { b0 = *(const f32x4*)(basef + off + bj * HALF); b1 = *(const f32x4*)(basef + off + bj * HALF + 4); }
                    else { const u32x4 w = *(const u32x4*)(baseb + off + bj * HALF);
                        b0 = (f32x4){__builtin_bit_cast(float, w.x << 16), __builtin_bit_cast(float, w.x & 0xffff0000u), __builtin_bit_cast(float, w.y << 16), __builtin_bit_cast(float, w.y & 0xffff0000u)};
                        b1 = (f32x4){__builtin_bit_cast(float, w.z << 16), __builtin_bit_cast(float, w.z & 0xffff0000u), __builtin_bit_cast(float, w.w << 16), __builtin_bit_cast(float, w.w & 0xffff0000u)}; }
                    const f32x4 v0 = b0 + acc[ai][bj][m][0], v1 = b1 + acc[ai][bj][m][1];
                    if (outf) { *(f32x4*)(outf + off + bj * HALF) = v0; *(f32x4*)(outf + off + bj * HALF + 4) = v1; }
                    if (outb) { u32x4 w; w.x = cvt_pk_bf16(v0[0], v0[1]); w.y = cvt_pk_bf16(v0[2], v0[3]); w.z = cvt_pk_bf16(v1[0], v1[1]); w.w = cvt_pk_bf16(v1[2], v1[3]); *(u32x4*)(outb + off + bj * HALF) = w; }
                    s += (v0[0] * v0[0] + v0[1] * v0[1]) + (v0[2] * v0[2] + v0[3] * v0[3]) + (v1[0] * v1[0] + v1[1] * v1[1]) + (v1[2] * v1[2] + v1[3] * v1[3]); }
                s += __shfl_xor(s, 16); s += __shfl_xor(s, 32);
                if (fq == 0) ssq[(size_t)row * 16 + u.pn * 4 + wc] = s;
                asm volatile("" ::: "memory"); }
    }
};

template <class Epi, class Sched, bool ALIGN_EPI = false, bool SP2 = false>
__device__ __forceinline__ void gemm_phase(PG8_LAS unsigned char* lds, const Gemm g, const Sched& S, const Epi& E) {
    const int tid = threadIdx.x, wid = __builtin_amdgcn_readfirstlane(tid >> 6), lane = tid & 63, wr = wid >> 2, wc = wid & 3, fr = lane & 15, fq = lane >> 4;
    const int K = g.K, nt = K / BK;
    unsigned voffA[2], voffB[2];
#pragma unroll
    for (int i = 0; i < 2; ++i) { int R, C; stage_rc(tid * 16 + i * 8192, R, C); const int Rb = Epi::PERM ? ((R & ~31) + perm32(R & 31)) : R;
        voffA[i] = (unsigned)(R * K + C) * 2u; voffB[i] = (unsigned)(Rb * K + C) * 2u; }
    const size_t kstep = (size_t)(BK * 2);
    const size_t hstep = (size_t)HALF * K * 2;
    const size_t tstep = 2 * hstep;
    const unsigned ldsw = (unsigned)wid * 1024u;
    const int aoff = lds_byte(wr * 64 + fr, fq * 8), boff = lds_byte(wc * 32 + fr, fq * 8);
#define PG8_SA(b, h) (((b) * 2 + (h)) * HTB)
#define PG8_SB(b, h) ((4 + (b) * 2 + (h)) * HTB)
#define PG8_STAGE(bufoff, gbase, voff) do { _Pragma("unroll") for (int _i = 0; _i < 2; ++_i) \
        __builtin_amdgcn_global_load_lds((const unsigned*)((const char*)(gbase) + (voff)[_i]), (PG8_LAS unsigned*)(lds + (bufoff) + ldsw + _i * 8192), 16, 0, 0); } while (0)
#define PG8_LDA(dst, b, h) do { _Pragma("unroll") for (int m = 0; m < 4; ++m) _Pragma("unroll") for (int k = 0; k < 2; ++k) dst[m][k] = *(const PG8_LAS bf16x8*)(lds + PG8_SA(b, h) + aoff + m * 2048 + k * 1024); } while (0)
#define PG8_LDB(dst, b, h) do { _Pragma("unroll") for (int n = 0; n < 2; ++n) _Pragma("unroll") for (int k = 0; k < 2; ++k) dst[n][k] = *(const PG8_LAS bf16x8*)(lds + PG8_SB(b, h) + boff + n * 2048 + k * 1024); } while (0)
#define PG8_MMA(ai, bj, At, Bt) do { __builtin_amdgcn_s_setprio(1); _Pragma("unroll") for (int m = 0; m < 4; ++m) _Pragma("unroll") for (int n = 0; n < 2; ++n) _Pragma("unroll") for (int k = 0; k < 2; ++k) \
        acc[ai][bj][m][n] = __builtin_amdgcn_mfma_f32_16x16x32_bf16(Bt[n][k], At[m][k], acc[ai][bj][m][n], 0, 0, 0); __builtin_amdgcn_s_setprio(0); } while (0)
#define PG8_WAIT_V(n) asm volatile("s_waitcnt vmcnt(" #n ")" ::: "memory")
#define PG8_WAIT_L(n) asm volatile("s_waitcnt lgkmcnt(" #n ")" ::: "memory")
#define PG8_BAR __builtin_amdgcn_s_barrier()
#define PG8_SCHED __builtin_amdgcn_sched_barrier(0)
    Unit cur, nxt; int ui = 0;
    if (!S.next(0, cur)) return;
    f32x4 acc[2][2][4][2];
#pragma unroll
    for (int a = 0; a < 2; ++a)
#pragma unroll
        for (int b = 0; b < 2; ++b)
#pragma unroll
            for (int m = 0; m < 4; ++m)
#pragma unroll
                for (int n = 0; n < 2; ++n) acc[a][b][m][n] = (f32x4){0.f, 0.f, 0.f, 0.f};
    bf16x8 At[4][2], B0[2][2], B1[2][2];
    const char* cA = (const char*)g.A + (size_t)cur.pm * tstep; const char* cB = (const char*)g.Bt + (size_t)cur.pn * tstep;
    S.a_ready(cur);
    if constexpr (SP2) {
        PG8_STAGE(PG8_SB(0, 0), cB, voffB); PG8_STAGE(PG8_SB(0, 1), cB + hstep, voffB); PG8_STAGE(PG8_SA(0, 0), cA, voffA); PG8_STAGE(PG8_SA(0, 1), cA + hstep, voffA);
        if (wr == 1) PG8_BAR;
        PG8_WAIT_V(2); PG8_BAR;
        PG8_STAGE(PG8_SB(1, 0), cB + kstep, voffB); PG8_STAGE(PG8_SA(1, 0), cA + kstep, voffA); PG8_STAGE(PG8_SB(1, 1), cB + hstep + kstep, voffB);
        PG8_WAIT_V(6); PG8_BAR;
    } else {
        PG8_STAGE(PG8_SB(0, 0), cB, voffB); PG8_STAGE(PG8_SA(0, 0), cA, voffA); PG8_STAGE(PG8_SB(0, 1), cB + hstep, voffB); PG8_STAGE(PG8_SA(0, 1), cA + hstep, voffA);
        if (wr == 1) PG8_BAR;
        PG8_WAIT_V(4); PG8_BAR;
        PG8_STAGE(PG8_SB(1, 0), cB + kstep, voffB); PG8_STAGE(PG8_SA(1, 0), cA + kstep, voffA); PG8_STAGE(PG8_SB(1, 1), cB + hstep + kstep, voffB);
        PG8_WAIT_V(6); PG8_BAR;
    }
    for (;;) {
        const bool has_next = S.next(ui + 1, nxt);
        const char* nA = has_next ? (const char*)g.A + (size_t)nxt.pm * tstep : cA; const char* nB = has_next ? (const char*)g.Bt + (size_t)nxt.pn * tstep : cB;
        for (int t = 0; t < nt; t += 2) {
            const bool last = (t == nt - 2);
            const char* a1 = cA + (size_t)(t + 1) * kstep;
            const char* a2 = last ? nA : cA + (size_t)(t + 2) * kstep; const char* b2 = last ? nB : cB + (size_t)(t + 2) * kstep;
            const char* a3 = a2 + kstep; const char* b3 = b2 + kstep;
            if (last && has_next) S.a_ready(nxt);
            if constexpr (SP2) {
            PG8_LDB(B0, 0, 0); PG8_LDB(B1, 0, 1); PG8_SCHED; PG8_LDA(At, 0, 0); PG8_STAGE(PG8_SA(1, 1), a1 + hstep, voffA);
            PG8_WAIT_V(8); PG8_WAIT_L(0); PG8_BAR; PG8_MMA(0, 0, At, B0); PG8_MMA(0, 1, At, B1); PG8_BAR; PG8_SCHED;
            PG8_LDA(At, 0, 1); PG8_STAGE(PG8_SB(0, 0), b2, voffB); PG8_STAGE(PG8_SB(0, 1), b2 + hstep, voffB); PG8_STAGE(PG8_SA(0, 0), a2, voffA);
            PG8_WAIT_V(8); PG8_WAIT_L(0); PG8_BAR; PG8_MMA(1, 0, At, B0); PG8_MMA(1, 1, At, B1); PG8_BAR; PG8_SCHED;
            PG8_LDB(B0, 1, 0); PG8_LDB(B1, 1, 1); PG8_SCHED; PG8_LDA(At, 1, 0); PG8_STAGE(PG8_SA(0, 1), a2 + hstep, voffA);
            PG8_WAIT_V(8); PG8_WAIT_L(0); PG8_BAR; PG8_MMA(0, 0, At, B0); PG8_MMA(0, 1, At, B1); PG8_BAR; PG8_SCHED;
            PG8_LDA(At, 1, 1); PG8_STAGE(PG8_SB(1, 0), b3, voffB); PG8_STAGE(PG8_SB(1, 1), b3 + hstep, voffB); PG8_STAGE(PG8_SA(1, 0), a3, voffA);
            PG8_WAIT_V(8); PG8_WAIT_L(0); PG8_BAR; PG8_MMA(1, 0, At, B0); PG8_MMA(1, 1, At, B1); PG8_BAR; PG8_SCHED;
            } else {
            PG8_LDB(B0, 0, 0); PG8_SCHED; PG8_LDA(At, 0, 0); PG8_STAGE(PG8_SA(1, 1), a1 + hstep, voffA);
            PG8_WAIT_L(8); PG8_BAR; PG8_WAIT_L(0); PG8_MMA(0, 0, At, B0); PG8_BAR; PG8_SCHED;
            PG8_LDB(B1, 0, 1); PG8_STAGE(PG8_SB(0, 0), b2, voffB);
            PG8_BAR; PG8_WAIT_L(0); PG8_MMA(0, 1, At, B1); PG8_BAR;
            PG8_LDA(At, 0, 1); PG8_STAGE(PG8_SA(0, 0), a2, voffA);
            PG8_BAR; PG8_WAIT_L(0); PG8_MMA(1, 0, At, B0); PG8_BAR; PG8_SCHED;
            PG8_STAGE(PG8_SB(0, 1), b2 + hstep, voffB);
            PG8_WAIT_V(6); PG8_BAR; PG8_MMA(1, 1, At, B1); PG8_BAR;
            PG8_LDB(B0, 1, 0); PG8_SCHED; PG8_LDA(At, 1, 0); PG8_STAGE(PG8_SA(0, 1), a2 + hstep, voffA);
            PG8_WAIT_L(8); PG8_BAR; PG8_WAIT_L(0); PG8_MMA(0, 0, At, B0); PG8_BAR; PG8_SCHED;
            PG8_LDB(B1, 1, 1); PG8_STAGE(PG8_SB(1, 0), b3, voffB);
            PG8_BAR; PG8_WAIT_L(0); PG8_MMA(0, 1, At, B1); PG8_BAR;
            PG8_LDA(At, 1, 1); PG8_STAGE(PG8_SA(1, 0), a3, voffA);
            PG8_BAR; PG8_WAIT_L(0); PG8_MMA(1, 0, At, B0); PG8_BAR; PG8_SCHED;
            PG8_STAGE(PG8_SB(1, 1), b3 + hstep, voffB);
            PG8_WAIT_V(6); PG8_BAR; PG8_MMA(1, 1, At, B1); PG8_BAR;
            }
        }
        if constexpr (ALIGN_EPI) { if (wr == 0) PG8_BAR; }
        if constexpr (!Epi::AFTER_DRAIN) { E(acc, cur, wr, wc, fr, fq); S.done(cur); }
        if (!has_next) break;
#pragma unroll
        for (int a = 0; a < 2; ++a)
#pragma unroll
            for (int b = 0; b < 2; ++b)
#pragma unroll
                for (int m = 0; m < 4; ++m)
#pragma unroll
                    for (int n = 0; n < 2; ++n) acc[a][b][m][n] = (f32x4){0.f, 0.f, 0.f, 0.f};
        cur = nxt; cA = nA; cB = nB; ++ui;
        if constexpr (ALIGN_EPI) { if (wr == 1) PG8_BAR; }
    }
    PG8_WAIT_V(0);
    if constexpr (!ALIGN_EPI) { if (wr == 0) PG8_BAR; }
    PG8_BAR;
    if constexpr (Epi::AFTER_DRAIN) { E.fused(acc, cur, wr, wc, fr, fq, lds, wid, lane); S.done(cur); }
#undef PG8_SA
#undef PG8_SB
#undef PG8_STAGE
#undef PG8_LDA
#undef PG8_LDB
#undef PG8_MMA
#undef PG8_WAIT_V
#undef PG8_WAIT_L
#undef PG8_BAR
#undef PG8_SCHED
}
}

#include <hip/hip_cooperative_groups.h>
namespace cg = cooperative_groups;

#define LAS __attribute__((address_space(3)))
typedef unsigned short bf16;
typedef unsigned v4u __attribute__((ext_vector_type(4)));
typedef unsigned v2u __attribute__((ext_vector_type(2)));
typedef float f32x4 __attribute__((ext_vector_type(4)));
typedef short bf16x8 __attribute__((ext_vector_type(8)));
typedef short s16x4 __attribute__((ext_vector_type(4)));

constexpr int NWAVES = 8, NT = NWAVES * 64;
constexpr int BATCH = 4, SEQ = 4096, D = 1024, M = BATCH * SEQ, FF = 4096, NH = 16, HD = 64, GW = 64, ROWS = 64, KH = 8, WW = 16;
constexpr size_t MiB = 1u << 20;
constexpr size_t WS_BAR = 0;
constexpr int BARST_OFF = 151552;
constexpr size_t WS_SSQ = 1 * MiB;
constexpr size_t WS_WIN = 4 * MiB, WS_WOUT = 10 * MiB, WS_WQKV = 12 * MiB, WS_WO = 18 * MiB, WS_WUP0 = 20 * MiB, WS_WUP1 = 28 * MiB, WS_WDN0 = 36 * MiB, WS_WDN1 = 44 * MiB;
constexpr size_t WS_XB = 52 * MiB;
constexpr size_t WS_U = 84 * MiB;
constexpr size_t WS_Y = 180 * MiB;
constexpr size_t WS_A = 84 * MiB;
constexpr size_t WS_END = 212 * MiB;
constexpr int LDS_BYTES = 152576;

__device__ __forceinline__ unsigned f2bf(float f) { unsigned u = __builtin_bit_cast(unsigned, f); return (u + 0x7fffu + ((u >> 16) & 1u)) >> 16; }
__device__ __forceinline__ unsigned pk2(float lo, float hi) { return f2bf(lo) | (f2bf(hi) << 16); }
__device__ __forceinline__ float bf_lo(unsigned w) { return __builtin_bit_cast(float, w << 16); }
__device__ __forceinline__ float bf_hi(unsigned w) { return __builtin_bit_cast(float, w & 0xffff0000u); }
#define LDS_WAIT() asm volatile("s_waitcnt lgkmcnt(0)" ::: "memory")

__device__ __forceinline__ float wave_sum(float v) {
#pragma unroll
    for (int o = 1; o < 64; o <<= 1) v += __shfl_xor(v, o);
    return v;
}

__device__ __forceinline__ void p0_transpose_item(const float* W, int K, int N, bf16* WT, const float* g, LAS float* scr, int item, int lane) {
    const int nblk = N / 32, kb = item / nblk, nb = item % nblk, k0 = 64 * kb, n0 = 32 * nb;
#pragma unroll 8
    for (int i = 0; i < 32; ++i) { const int kk = 2 * i + (lane >> 5); float w = W[(size_t)(k0 + kk) * N + n0 + (lane & 31)]; if (g) w *= g[k0 + kk]; scr[kk * 33 + (lane & 31)] = w; }
    LDS_WAIT(); asm volatile("" ::: "memory");
    const int c = lane & 7;
#pragma unroll
    for (int j = 0; j < 4; ++j) { const int n = (lane >> 3) + 8 * j; const LAS float* s = scr + (8 * c) * 33 + n;
        v4u o; o.x = pk2(s[0 * 33], s[1 * 33]); o.y = pk2(s[2 * 33], s[3 * 33]); o.z = pk2(s[4 * 33], s[5 * 33]); o.w = pk2(s[6 * 33], s[7 * 33]);
        *(v4u*)(WT + (size_t)(n0 + n) * K + k0 + 8 * c) = o; }
    LDS_WAIT(); asm volatile("" ::: "memory");
}

#define XB_TMO      128
#define XB_XCNT(j)  (256  + 64 * (j))
#define XB_XSUB(j)  (1280 + 64 * (j))
#define XB_XGEN(j)  (2304 + 64 * (j))
#define XB_TOP      3328
#define XB_TOPGEN   3392
#define XCD_BAR_WORDS 3456
#define XB_SPIN_CAP (1u << 18)

__device__ __forceinline__ unsigned xb_ld(unsigned* p)              { return __hip_atomic_load(p, __ATOMIC_RELAXED, __HIP_MEMORY_SCOPE_AGENT); }
__device__ __forceinline__ unsigned xb_add(unsigned* p, unsigned v) { return __hip_atomic_fetch_add(p, v, __ATOMIC_RELAXED, __HIP_MEMORY_SCOPE_AGENT); }
__device__ __forceinline__ unsigned xb_xcc_id() { return (unsigned)__builtin_amdgcn_s_getreg((3 << 11) | 20) & 0xFu; }
#define XB_SPIN(cond, bar) do { unsigned _sp = 0; while (cond) { __builtin_amdgcn_s_sleep(1); \
    if ((++_sp & 255u) == 0u) { if (xb_ld(&(bar)[XB_TMO])) break; if (_sp > XB_SPIN_CAP) { atomicAdd(&(bar)[XB_TMO], 1u); break; } } } } while (0)

struct XcdBarrier {
    unsigned* bar; unsigned x;
    volatile LAS unsigned* st;
};

__device__ __forceinline__ XcdBarrier xcd_barrier_post(unsigned* bar, volatile LAS unsigned* st) {
    XcdBarrier b; b.bar = bar; b.x = xb_xcc_id(); b.st = st;
    if (threadIdx.x == 0) (void)xb_add(&bar[XB_XCNT(b.x)], 1u);
    return b;
}
__device__ __forceinline__ void xcd_barrier_complete(unsigned* bar, unsigned x, unsigned& nloc, unsigned& nx) {
    const unsigned G = gridDim.x * gridDim.y * gridDim.z;
    unsigned sum, cnt, mine, sp = 0u;
    for (;;) {
        sum = 0u; cnt = 0u; mine = 0u;
#pragma unroll
        for (unsigned j = 0; j < 16; ++j) { const unsigned c = xb_ld(&bar[XB_XCNT(j)]); sum += c; cnt += (c > 0u) ? 1u : 0u; mine = (j == x) ? c : mine; }
        if (sum == G) break;
        __builtin_amdgcn_s_sleep(1);
        if ((++sp & 255u) == 0u) { if (xb_ld(&bar[XB_TMO])) break; if (sp > XB_SPIN_CAP) { atomicAdd(&bar[XB_TMO], 1u); break; } }
    }
    nloc = mine > 0u ? mine : 1u; nx = cnt > 0u ? cnt : 1u;
}

__device__ __forceinline__ void xcd_barrier(const XcdBarrier& b) {
    asm volatile("s_waitcnt vmcnt(0)" ::: "memory");
    __syncthreads();
    if (threadIdx.x == 0) {
        unsigned* bar = b.bar;
        __builtin_amdgcn_s_waitcnt(0);
        unsigned nloc = b.st[0], nx = b.st[1];
        if (nloc == 0u) { xcd_barrier_complete(bar, b.x, nloc, nx); b.st[0] = nloc; b.st[1] = nx; }
        const unsigned old = xb_add(&bar[XB_XSUB(b.x)], 1u);
        const unsigned gen = old / nloc;
        if (old + 1u == (gen + 1u) * nloc) {
            __builtin_amdgcn_fence(__ATOMIC_RELEASE, "agent");
            asm volatile("s_waitcnt vmcnt(0)" ::: "memory");
            const unsigned og = xb_add(&bar[XB_TOP], 1u);
            const unsigned tg = og / nx;
            if (og + 1u == (tg + 1u) * nx) xb_add(&bar[XB_TOPGEN], 1u);
            else XB_SPIN(xb_ld(&bar[XB_TOPGEN]) == tg, bar);
            __builtin_amdgcn_fence(__ATOMIC_ACQUIRE, "agent");
            xb_add(&bar[XB_XGEN(b.x)], 1u);
            asm volatile("s_waitcnt vmcnt(0)" ::: "memory");
        } else {
            XB_SPIN(xb_ld(&bar[XB_XGEN(b.x)]) == gen, bar);
            __builtin_amdgcn_fence(__ATOMIC_ACQUIRE, "agent");
            asm volatile("s_waitcnt vmcnt(0)" ::: "memory");
        }
    }
    __syncthreads();
}

struct Args {
    const float* x; const float* norm_mix; const float* conv_w_in; const float* conv_w; const float* conv_w_out; const float* attn_w_qkv; const float* attn_rpb; const float* attn_w_o;
    const float* norm_mlp; const float* mlp_w_up; const float* mlp_w_down; const float* norm_final; float* out; unsigned char* ws;
};

__device__ __forceinline__ void p0_prologue(const Args& a, LAS unsigned char* lds, int gw, int NGW, int wave, int lane) {
    LAS float* scr = (LAS float*)(lds + wave * 16384);
    unsigned char* ws = a.ws;
    constexpr int I_IN = 16 * 96, I_SQ = 16 * 32, I_UP = 16 * 128, I_DN = 64 * 32;
    constexpr int NITEMS = 2 * I_IN + 2 * I_SQ + 2 * I_UP + 2 * I_DN;
    for (int it = gw; it < NITEMS; it += NGW) {
        int r = it;
        if (r < I_IN) { p0_transpose_item(a.conv_w_in, D, 3 * D, (bf16*)(ws + WS_WIN), a.norm_mix, scr, r, lane); continue; } r -= I_IN;
        if (r < I_IN) { p0_transpose_item(a.attn_w_qkv, D, 3 * D, (bf16*)(ws + WS_WQKV), a.norm_mix + D, scr, r, lane); continue; } r -= I_IN;
        if (r < I_SQ) { p0_transpose_item(a.conv_w_out, D, D, (bf16*)(ws + WS_WOUT), nullptr, scr, r, lane); continue; } r -= I_SQ;
        if (r < I_SQ) { p0_transpose_item(a.attn_w_o, D, D, (bf16*)(ws + WS_WO), nullptr, scr, r, lane); continue; } r -= I_SQ;
        if (r < I_UP) { p0_transpose_item(a.mlp_w_up, D, FF, (bf16*)(ws + WS_WUP0), a.norm_mlp, scr, r, lane); continue; } r -= I_UP;
        if (r < I_UP) { p0_transpose_item(a.mlp_w_up + (size_t)D * FF, D, FF, (bf16*)(ws + WS_WUP1), a.norm_mlp + D, scr, r, lane); continue; } r -= I_UP;
        if (r < I_DN) { p0_transpose_item(a.mlp_w_down, FF, D, (bf16*)(ws + WS_WDN0), nullptr, scr, r, lane); continue; } r -= I_DN;
        p0_transpose_item(a.mlp_w_down + (size_t)FF * D, FF, D, (bf16*)(ws + WS_WDN1), nullptr, scr, r, lane);
    }
    bf16* XB = (bf16*)(ws + WS_XB); float* SSQ = (float*)(ws + WS_SSQ);
    for (int m = gw; m < M; m += NGW) {
        const f32x4* xr = (const f32x4*)(a.x + (size_t)m * D) + lane; f32x4 v[4]; float s = 0.f;
#pragma unroll
        for (int j = 0; j < 4; ++j) { v[j] = xr[64 * j]; s += (v[j].x * v[j].x + v[j].y * v[j].y) + (v[j].z * v[j].z + v[j].w * v[j].w); }
        s = wave_sum(s);
        v2u* o8 = (v2u*)(XB + (size_t)m * D) + lane;
#pragma unroll
        for (int j = 0; j < 4; ++j) { v2u o; o.x = pk2(v[j].x, v[j].y); o.y = pk2(v[j].z, v[j].w); o8[64 * j] = o; }
        if (lane < 16) SSQ[(size_t)m * 16 + lane] = (lane == 0) ? s : 0.f;
    }
}

__device__ __forceinline__ void conv_phase(const Args& a, int gw, int NGW, int lane) {
    const bf16* U = (const bf16*)(a.ws + WS_U); bf16* Y = (bf16*)(a.ws + WS_Y);
    constexpr int TCH = 16, NTASK = (M / TCH) * 2;
    for (int task = gw; task < NTASK; task += NGW) {
        const int ch = task >> 1, hf = task & 1, t0 = ch * TCH, d0 = hf * 512 + lane * 8;
        float w0[8], w1[8], w2[8];
#pragma unroll
        for (int e = 0; e < 8; ++e) { w0[e] = a.conv_w[d0 + e]; w1[e] = a.conv_w[D + d0 + e]; w2[e] = a.conv_w[2 * D + d0 + e]; }
        float zp[8], zc[8], zn[8];
        auto loadz = [&](int t, float* z) {
            const v4u c = *(const v4u*)(U + (size_t)t * (3 * D) + D + d0), v = *(const v4u*)(U + (size_t)t * (3 * D) + 2 * D + d0);
            z[0] = bf_lo(c.x) * bf_lo(v.x); z[1] = bf_hi(c.x) * bf_hi(v.x); z[2] = bf_lo(c.y) * bf_lo(v.y); z[3] = bf_hi(c.y) * bf_hi(v.y);
            z[4] = bf_lo(c.z) * bf_lo(v.z); z[5] = bf_hi(c.z) * bf_hi(v.z); z[6] = bf_lo(c.w) * bf_lo(v.w); z[7] = bf_hi(c.w) * bf_hi(v.w); };
        if ((t0 & (SEQ - 1)) == 0) {
#pragma unroll
            for (int e = 0; e < 8; ++e) zp[e] = 0.f; } else loadz(t0 - 1, zp);
        loadz(t0, zc);
        for (int i = 0; i < TCH; ++i) {
            const int t = t0 + i;
            if (((t + 1) & (SEQ - 1)) == 0) {
#pragma unroll
                for (int e = 0; e < 8; ++e) zn[e] = 0.f; } else loadz(t + 1, zn);
            const v4u bb = *(const v4u*)(U + (size_t)t * (3 * D) + d0);
            float bv[8] = {bf_lo(bb.x), bf_hi(bb.x), bf_lo(bb.y), bf_hi(bb.y), bf_lo(bb.z), bf_hi(bb.z), bf_lo(bb.w), bf_hi(bb.w)};
            float y[8];
#pragma unroll
            for (int e = 0; e < 8; ++e) y[e] = bv[e] * (w0[e] * zp[e] + w1[e] * zc[e] + w2[e] * zn[e]);
            v4u o; o.x = pk2(y[0], y[1]); o.y = pk2(y[2], y[3]); o.z = pk2(y[4], y[5]); o.w = pk2(y[6], y[7]);
            *(v4u*)(Y + (size_t)t * D + d0) = o;
#pragma unroll
            for (int e = 0; e < 8; ++e) { zp[e] = zc[e]; zc[e] = zn[e]; }
        }
    }
}

constexpr int AT_K = 0, AT_V = 73728, AT_B = 147456;
__device__ __forceinline__ int swz(int col) { return ((col >> 1) & 1) | (((col >> 3) & 3) << 1); }
__device__ __forceinline__ int rstart(int r) { return min(max(r - KH / 2, 0), ROWS - KH); }
__device__ __forceinline__ void attn_phase(const Args& a, LAS unsigned char* lds, int G, int bid, int tid) {
    const bf16* QKV = (const bf16*)(a.ws + WS_U); bf16* Y = (bf16*)(a.ws + WS_Y);
    LAS unsigned char* Kl = lds + AT_K; LAS unsigned char* Vl = lds + AT_V; LAS float* Bl = (LAS float*)(lds + AT_B);
    const int wave = __builtin_amdgcn_readfirstlane(tid >> 6), lane = tid & 63, g = lane >> 4, qi = lane & 15;
    const int j = wave & 3, wr = wave >> 2;
    const int c0 = (j == 0) ? 0 : (j == 1) ? 8 : (j == 2) ? 24 : 32;
    const int c = 16 * j + qi, cs = min(max(c - WW / 2, 0), GW - WW);
    int baddr[8];
#pragma unroll
    for (int T = 0; T < 2; ++T)
#pragma unroll
        for (int e = 0; e < 4; ++e) { const int kcol = c0 + 8 * g + 4 * T + e; const bool ok = (kcol >= cs) && (kcol < cs + WW); baddr[T * 4 + e] = AT_B + (ok ? (kcol - c + 15) : 31) * 4; }
    const int lcol = tid >> 3, lchunk = tid & 7, loff = (lcol << 7) + ((lchunk ^ swz(lcol)) << 4);
    const int kcolA = c0 + 8 * (qi >> 2) + (qi & 3);
    const int vq = qi >> 2, vp = qi & 3, vcol = c0 + 8 * g + vq, vsw = swz(vcol);
    const float SC = 0.125f * 1.4426950408889634f;
    for (int st = bid; st < BATCH * NH * 4; st += G) {
        const int b = st >> 6, h = (st >> 2) & 15, seg = st & 3, r0 = seg * 16;
        const bf16* kvsrc = QKV + ((size_t)b * SEQ + lcol) * (3 * D) + D + h * HD + lchunk * 8;
        __syncthreads();
        { const int row = tid >> 5, col = tid & 31; Bl[tid] = (row < 15 && col < 31) ? a.attn_rpb[h * 465 + row * 31 + col] * 1.4426950408889634f : -INFINITY; }
        int hi = rstart(r0 + 1) + 7;
        for (int row = rstart(r0); row <= hi; ++row) { const bf16* p = kvsrc + (size_t)row * (GW * 3 * D); const v4u k = *(const v4u*)p, v = *(const v4u*)(p + D);
            const int off = (row % 9) * 8192 + loff; *(LAS v4u*)(Kl + off) = k; *(LAS v4u*)(Vl + off) = v; }
        v4u pk0, pv0, pk1, pv1; int npre = 0;
        pk0 = pv0 = pk1 = pv1 = (v4u){0u, 0u, 0u, 0u};
        bf16x8 q0, q1;
        { const size_t qtok = (size_t)b * SEQ + (r0 + wr) * GW + c; q0 = *(const bf16x8*)(QKV + qtok * (3 * D) + h * HD + g * 8); q1 = *(const bf16x8*)(QKV + qtok * (3 * D) + h * HD + 32 + g * 8); }
        for (int p = 0; p < 8; ++p) {
            const int r = r0 + 2 * p;
            if (p > 0) {
                __syncthreads();
                if (npre > 0) { const int off = ((hi + 1) % 9) * 8192 + loff; *(LAS v4u*)(Kl + off) = pk0; *(LAS v4u*)(Vl + off) = pv0; }
                if (npre > 1) { const int off = ((hi + 2) % 9) * 8192 + loff; *(LAS v4u*)(Kl + off) = pk1; *(LAS v4u*)(Vl + off) = pv1; }
                hi += npre;
            }
            __syncthreads();
            bf16x8 q0n = q0, q1n = q1;
            if (p < 7) {
                npre = rstart(r + 3) + 7 - hi;
                if (npre > 0) { const bf16* pp = kvsrc + (size_t)(hi + 1) * (GW * 3 * D); pk0 = *(const v4u*)pp; pv0 = *(const v4u*)(pp + D); }
                if (npre > 1) { const bf16* pp = kvsrc + (size_t)(hi + 2) * (GW * 3 * D); pk1 = *(const v4u*)pp; pv1 = *(const v4u*)(pp + D); }
                const size_t qtok = (size_t)b * SEQ + (r + 2 + wr) * GW + c; q0n = *(const bf16x8*)(QKV + qtok * (3 * D) + h * HD + g * 8); q1n = *(const bf16x8*)(QKV + qtok * (3 * D) + h * HD + 32 + g * 8);
            }
            {
                const int rr = r + wr, s = rstart(rr); const int sl = s % 9;
                const int roffb = (s - rr + 7) * 128;
                f32x4 sc[8][2];
                float mx = -INFINITY;
#pragma unroll
                for (int i = 0; i < 8; ++i) {
                    const int slot = (sl + i >= 9) ? sl + i - 9 : sl + i;
#pragma unroll
                    for (int T = 0; T < 2; ++T) {
                        const int kc = kcolA + 4 * T; const int base = slot * 8192 + (kc << 7), sw = swz(kc);
                        const bf16x8 k0 = *(const LAS bf16x8*)(Kl + base + ((g ^ sw) << 4)), k1 = *(const LAS bf16x8*)(Kl + base + (((4 + g) ^ sw) << 4));
                        f32x4 acc = (f32x4){0.f, 0.f, 0.f, 0.f};
                        acc = __builtin_amdgcn_mfma_f32_16x16x32_bf16(k0, q0, acc, 0, 0, 0);
                        acc = __builtin_amdgcn_mfma_f32_16x16x32_bf16(k1, q1, acc, 0, 0, 0);
#pragma unroll
                        for (int e = 0; e < 4; ++e) { const float bias = *(const LAS float*)(lds + baddr[T * 4 + e] + roffb + i * 128); const float v = acc[e] * SC + bias; acc[e] = v; mx = fmaxf(mx, v); }
                        sc[i][T] = acc;
                    }
                }
                mx = fmaxf(mx, __shfl_xor(mx, 16)); mx = fmaxf(mx, __shfl_xor(mx, 32));
                float sum = 0.f;
#pragma unroll
                for (int i = 0; i < 8; ++i)
#pragma unroll
                    for (int T = 0; T < 2; ++T)
#pragma unroll
                        for (int e = 0; e < 4; ++e) { const float pe = __builtin_amdgcn_exp2f(sc[i][T][e] - mx); sc[i][T][e] = pe; sum += pe; }
                sum += __shfl_xor(sum, 16); sum += __shfl_xor(sum, 32);
                f32x4 o[4];
#pragma unroll
                for (int dt = 0; dt < 4; ++dt) o[dt] = (f32x4){0.f, 0.f, 0.f, 0.f};
#pragma unroll
                for (int i = 0; i < 8; ++i) {
                    const int slot = (sl + i >= 9) ? sl + i - 9 : sl + i;
                    v4u pw; pw.x = pg8::cvt_pk_bf16(sc[i][0][0], sc[i][0][1]); pw.y = pg8::cvt_pk_bf16(sc[i][0][2], sc[i][0][3]); pw.z = pg8::cvt_pk_bf16(sc[i][1][0], sc[i][1][1]); pw.w = pg8::cvt_pk_bf16(sc[i][1][2], sc[i][1][3]);
                    const bf16x8 pf = __builtin_bit_cast(bf16x8, pw);
                    const int vbase = slot * 8192 + (vcol << 7) + (vp & 1) * 8;
#pragma unroll
                    for (int dt = 0; dt < 4; ++dt) {
                        const int ch = ((dt * 2 + (vp >> 1)) ^ vsw) << 4;
                        const s16x4 lo = __builtin_bit_cast(s16x4, __builtin_amdgcn_ds_read_tr16_b64_v4i16((LAS s16x4*)(Vl + vbase + ch)));
                        const s16x4 hi4 = __builtin_bit_cast(s16x4, __builtin_amdgcn_ds_read_tr16_b64_v4i16((LAS s16x4*)(Vl + vbase + ch + 512)));
                        bf16x8 vf; vf[0] = lo[0]; vf[1] = lo[1]; vf[2] = lo[2]; vf[3] = lo[3]; vf[4] = hi4[0]; vf[5] = hi4[1]; vf[6] = hi4[2]; vf[7] = hi4[3];
                        o[dt] = __builtin_amdgcn_mfma_f32_16x16x32_bf16(vf, pf, o[dt], 0, 0, 0);
                    }
                }
                const float inv = 1.0f / sum;
                bf16* yp = Y + ((size_t)b * SEQ + rr * GW + c) * D + h * HD + 4 * g;
#pragma unroll
                for (int dt = 0; dt < 4; ++dt) { v2u w; w.x = pg8::cvt_pk_bf16(o[dt][0] * inv, o[dt][1] * inv); w.y = pg8::cvt_pk_bf16(o[dt][2] * inv, o[dt][3] * inv); *(v2u*)(yp + dt * 16) = w; }
            }
            q0 = q0n; q1 = q1n;
        }
    }
}

__device__ __forceinline__ void final_norm(const Args& a, int gw, int NGW, int lane) {
    const float* SSQ = (const float*)(a.ws + WS_SSQ);
    f32x4 gv[4];
#pragma unroll
    for (int j = 0; j < 4; ++j) gv[j] = ((const f32x4*)a.norm_final)[lane + 64 * j];
    for (int m = gw; m < M; m += NGW) {
        const float rs = pg8::row_rstd(SSQ, m);
        f32x4* xr = (f32x4*)(a.out + (size_t)m * D) + lane;
#pragma unroll
        for (int j = 0; j < 4; ++j) { f32x4 v = xr[64 * j]; v = v * rs * gv[j]; xr[64 * j] = v; }
    }
}

__global__ void __launch_bounds__(NT) fwd_megakernel(Args a) {
    extern __shared__ __attribute__((aligned(16))) unsigned char lds_raw[];
    LAS unsigned char* lds = (LAS unsigned char*)lds_raw;
    cg::grid_group grid = cg::this_grid();
    const int tid = threadIdx.x, lane = tid & 63, wave = __builtin_amdgcn_readfirstlane(tid >> 6);
    const int G = gridDim.x, bid = blockIdx.x, gw = bid * NWAVES + wave, NGW = G * NWAVES;
    unsigned char* ws = a.ws;
    bf16* XB = (bf16*)(ws + WS_XB); bf16* U = (bf16*)(ws + WS_U); bf16* Y = (bf16*)(ws + WS_Y); bf16* A = (bf16*)(ws + WS_A); float* SSQ = (float*)(ws + WS_SSQ);

    if (bid == 0) for (int i = tid; i < XCD_BAR_WORDS; i += NT) __hip_atomic_store((unsigned*)(ws + WS_BAR) + i, 0u, __ATOMIC_RELAXED, __HIP_MEMORY_SCOPE_AGENT);
    if (tid < 2) ((volatile LAS unsigned*)(lds + BARST_OFF))[tid] = 0u;
    p0_prologue(a, lds, gw, NGW, wave, lane);
    grid.sync();
    const XcdBarrier bar = xcd_barrier_post((unsigned*)(ws + WS_BAR), (volatile LAS unsigned*)(lds + BARST_OFF));
    { pg8::Gemm g{XB, (const bf16*)(ws + WS_WIN), M, 3 * D, D}; pg8::StaticOrder S; S.init(M, 3 * D, G, bid); pg8::EpiScale<0> E{U, 3 * D, SSQ};
      pg8::gemm_phase<pg8::EpiScale<0>, pg8::StaticOrder, true, true>(lds, g, S, E); }
    xcd_barrier(bar);
    conv_phase(a, gw, NGW, lane);
    xcd_barrier(bar);
    { pg8::Gemm g{Y, (const bf16*)(ws + WS_WOUT), M, D, D}; pg8::StaticOrder S; S.init(M, D, G, bid); pg8::EpiResid E{a.x, nullptr, nullptr, XB, SSQ};
      pg8::gemm_phase<pg8::EpiResid, pg8::StaticOrder, true, true>(lds, g, S, E); }
    xcd_barrier(bar);
    { pg8::Gemm g{XB, (const bf16*)(ws + WS_WUP0), M, FF, D}; pg8::StaticOrder S; S.init(M, FF, G, bid); pg8::EpiScale<1> E{A, FF, SSQ};
      pg8::gemm_phase<pg8::EpiScale<1>, pg8::StaticOrder, true, true>(lds, g, S, E); }
    xcd_barrier(bar);
    { pg8::Gemm g{A, (const bf16*)(ws + WS_WDN0), M, D, FF}; pg8::StaticOrder S; S.init(M, D, G, bid); pg8::EpiResid E{nullptr, XB, nullptr, XB, SSQ};
      pg8::gemm_phase<pg8::EpiResid, pg8::StaticOrder, true, true>(lds, g, S, E); }
    xcd_barrier(bar);
    { pg8::Gemm g{XB, (const bf16*)(ws + WS_WQKV), M, 3 * D, D}; pg8::StaticOrder S; S.init(M, 3 * D, G, bid); pg8::EpiScale<0> E{U, 3 * D, SSQ};
      pg8::gemm_phase<pg8::EpiScale<0>, pg8::StaticOrder, true, true>(lds, g, S, E); }
    xcd_barrier(bar);
    attn_phase(a, lds, G, bid, tid);
    xcd_barrier(bar);
    { pg8::Gemm g{Y, (const bf16*)(ws + WS_WO), M, D, D}; pg8::StaticOrder S; S.init(M, D, G, bid); pg8::EpiResid E{nullptr, XB, nullptr, XB, SSQ};
      pg8::gemm_phase<pg8::EpiResid, pg8::StaticOrder, true, true>(lds, g, S, E); }
    xcd_barrier(bar);
    { pg8::Gemm g{XB, (const bf16*)(ws + WS_WUP1), M, FF, D}; pg8::StaticOrder S; S.init(M, FF, G, bid); pg8::EpiScale<1> E{A, FF, SSQ};
      pg8::gemm_phase<pg8::EpiScale<1>, pg8::StaticOrder, true, true>(lds, g, S, E); }
    xcd_barrier(bar);
    { pg8::Gemm g{A, (const bf16*)(ws + WS_WDN1), M, D, FF}; pg8::StaticOrder S; S.init(M, D, G, bid); pg8::EpiResid E{nullptr, XB, a.out, nullptr, SSQ};
      pg8::gemm_phase<pg8::EpiResid, pg8::StaticOrder, true, true>(lds, g, S, E); }
    xcd_barrier(bar);
    final_norm(a, gw, NGW, lane);
}

extern "C" void kernel_launch(void* const* d_in, const int* in_sizes, int n_in, void* d_out, int out_size, void* d_ws, size_t ws_size, hipStream_t stream) {
    static int grid = 0;
    if (grid == 0) {
        if (n_in != 12 || in_sizes[0] != M * D || out_size != M * D || ws_size < WS_END) { fprintf(stderr, "kernel_launch: unexpected shapes (n_in %d, in0 %d, out %d, ws %zu)\n", n_in, n_in > 0 ? in_sizes[0] : -1, out_size, ws_size); grid = -1; return; }
        int dev = 0, cus = 0, per_cu = 0;
        (void)hipGetDevice(&dev); (void)hipDeviceGetAttribute(&cus, hipDeviceAttributeMultiprocessorCount, dev);
        (void)hipFuncSetAttribute((const void*)fwd_megakernel, hipFuncAttributeMaxDynamicSharedMemorySize, LDS_BYTES);
        (void)hipOccupancyMaxActiveBlocksPerMultiprocessor(&per_cu, (const void*)fwd_megakernel, NT, LDS_BYTES);
        if (per_cu < 1) { fprintf(stderr, "kernel_launch: occupancy query says %d blocks per CU\n", per_cu); per_cu = 1; }
        (void)hipGetLastError();
        grid = cus * per_cu;
    }
    if (grid < 0) return;
    Args a{};
    a.x = (const float*)d_in[0]; a.norm_mix = (const float*)d_in[1]; a.conv_w_in = (const float*)d_in[2]; a.conv_w = (const float*)d_in[3]; a.conv_w_out = (const float*)d_in[4];
    a.attn_w_qkv = (const float*)d_in[5]; a.attn_rpb = (const float*)d_in[6]; a.attn_w_o = (const float*)d_in[7]; a.norm_mlp = (const float*)d_in[8]; a.mlp_w_up = (const float*)d_in[9];
    a.mlp_w_down = (const float*)d_in[10]; a.norm_final = (const float*)d_in[11]; a.out = (float*)d_out; a.ws = (unsigned char*)d_ws;
    void* args[] = {&a};
    hipError_t e = hipLaunchCooperativeKernel((const void*)fwd_megakernel, dim3(grid), dim3(NT), args, LDS_BYTES, stream);
    if (e != hipSuccess) fprintf(stderr, "kernel_launch: cooperative launch failed: %s (grid %d)\n", hipGetErrorString(e), grid);
}
```

```cpp
#include <hip/hip_runtime.h>
#include <cstdio>
#include <cstdint>
namespace pg8 {
#define PG8_LAS __attribute__((address_space(3)))
typedef unsigned short bf16_t;
typedef short bf16x8 __attribute__((ext_vector_type(8)));
typedef float f32x4 __attribute__((ext_vector_type(4)));
typedef unsigned u32x4 __attribute__((ext_vector_type(4)));
constexpr int BM = 256, BK = 64, HALF = 128, HTB = HALF * BK * 2  , STAGE_BYTES = 8 * HTB, NXCD = 8, WGM = 8;

__host__ __device__ __forceinline__ int lds_byte(int r, int c) { const int st = (r >> 4) * 2 + (c >> 5), rr = r & 15, cc = c & 31, ob = rr * 64 + cc * 2; return st * 1024 + (ob ^ (((ob >> 9) & 1) << 5)); }
__host__ __device__ __forceinline__ void stage_rc(int b, int& R, int& C) { const int st = b / 1024, sb = b % 1024, swz = sb ^ (((sb >> 9) & 1) << 5); R = (st >> 1) * 16 + swz / 64; C = (st & 1) * 32 + (swz % 64) / 2; }
__host__ __device__ __forceinline__ int perm32(int rho) { const int n = rho >> 4, i = rho & 15; return 8 * (i >> 2) + 4 * n + (i & 3); }

struct Unit { int pm, pn; };
struct Gemm { const bf16_t* A; const bf16_t* Bt; int M, N, K; };

struct StaticOrder {
    int nM, nN, nwg, G, c;
    __host__ __device__ void init(int M, int N, int G_, int c_) { nM = M / BM; nN = N / BM; nwg = nM * nN; G = G_; c = c_; }
    __host__ __device__ bool next(int i, Unit& u) const {
        const long L = (long)i * G + c; if (L >= nwg) return false;
        int wgid = (int)L; { const int q = nwg / NXCD, r = nwg % NXCD, xcd = wgid % NXCD, off = wgid / NXCD; wgid = (xcd < r ? xcd * (q + 1) : r * (q + 1) + (xcd - r) * q) + off; }
        const int nig = WGM * nN, gid = wgid / nig, fm = gid * WGM, gsz = (nM - fm) < WGM ? (nM - fm) : WGM;
        u.pm = fm + ((wgid % nig) % gsz); u.pn = (wgid % nig) / gsz; return true;
    }
    __device__ __forceinline__ void a_ready(const Unit&) const {}
    __device__ __forceinline__ void done(const Unit&) const {}
};

__device__ __forceinline__ unsigned cvt_pk_bf16(float lo, float hi) { unsigned r; asm volatile("v_cvt_pk_bf16_f32 %0, %1, %2" : "=v"(r) : "v"(lo), "v"(hi)); return r; }
typedef float f32x2 __attribute__((ext_vector_type(2)));

__device__ __forceinline__ float row_rstd(const float* ssq, int row) {
    const f32x4* p = (const f32x4*)(ssq + (size_t)row * 16);
    const f32x4 a = p[0], b = p[1], c = p[2], d = p[3];
    const f32x4 s = (a + b) + (c + d);
    const float t = (s[0] + s[1]) + (s[2] + s[3]);
    return 1.0f / sqrtf(t * (1.0f / 1024.0f) + 1e-6f);
}
template <int ACT> struct EpiScale {
    static constexpr bool PERM = true, AFTER_DRAIN = false;
    bf16_t* O; int ldc; const float* ssq;
    __device__ __forceinline__ void operator()(const f32x4 (&acc)[2][2][4][2], const Unit& u, int wr, int wc, int fr, int fq) const {
        const int row0 = u.pm * BM + wr * 64 + fr; const int col0 = u.pn * BM + wc * 32 + 8 * fq;
#pragma unroll
        for (int ai = 0; ai < 2; ++ai)
#pragma unroll
            for (int m = 0; m < 4; ++m) { const int row = row0 + ai * HALF + m * 16; const float rs = row_rstd(ssq, row); bf16_t* rowp = O + (size_t)row * ldc + col0;
#pragma unroll
                for (int bj = 0; bj < 2; ++bj) { f32x4 v0 = acc[ai][bj][m][0] * rs, v1 = acc[ai][bj][m][1] * rs;
                    if (ACT == 1) {
#pragma unroll
                        for (int e = 0; e < 4; ++e) { const float a = fmaxf(v0[e], 0.f), b = fmaxf(v1[e], 0.f); v0[e] = a * a; v1[e] = b * b; } }
                    u32x4 w; w.x = cvt_pk_bf16(v0[0], v0[1]); w.y = cvt_pk_bf16(v0[2], v0[3]); w.z = cvt_pk_bf16(v1[0], v1[1]); w.w = cvt_pk_bf16(v1[2], v1[3]);
                    *(u32x4*)(rowp + bj * HALF) = w; } }
    }
};
struct EpiResid {
    static constexpr bool PERM = true, AFTER_DRAIN = false;
    const float* basef; const bf16_t* baseb; float* outf; bf16_t* outb; float* ssq;
    __device__ __forceinline__ void operator()(const f32x4 (&acc)[2][2][4][2], const Unit& u, int wr, int wc, int fr, int fq) const {
        const int row0 = u.pm * BM + wr * 64 + fr; const int col0 = u.pn * BM + wc * 32 + 8 * fq;
#pragma unroll
        for (int ai = 0; ai < 2; ++ai)
#pragma unroll
            for (int m = 0; m < 4; ++m) { const int row = row0 + ai * HALF + m * 16; const size_t off = (size_t)row * 1024 + col0; float s = 0.f;
#pragma unroll
                for (int bj = 0; bj < 2; ++bj) { f32x4 b0, b1;
                    if (basef) { b0 = *(const f32x4*)(basef + off + bj * HALF); b1 = *(const f32x4*)(basef + off + bj * HALF + 4); }
                    else { const u32x4 w = *(const u32x4*)(baseb + off + bj * HALF);
                        b0 = (f32x4){__builtin_bit_cast(float, w.x << 16), __builtin_bit_cast(float, w.x & 0xffff0000u), __builtin_bit_cast(float, w.y << 16), __builtin_bit_cast(float, w.y & 0xffff0000u)};
                        b1 = (f32x4){__builtin_bit_cast(float, w.z << 16), __builtin_bit_cast(float, w.z & 0xffff0000u), __builtin_bit_cast(float, w.w << 16), __builtin_bit_cast(float, w.w & 0xffff0000u)}; }
                    const f32x4 v0 = b0 + acc[ai][bj][m][0], v1 = b1 + acc[ai][bj][m][1];
                    if (outf) { *(f32x4*)(outf + off + bj * HALF) = v0; *(f32x4*)(outf + off + bj * HALF + 4) = v1; }
                    if (outb) { u32x4 w; w.x = cvt_pk_bf16(v0[0], v0[1]); w.y = cvt_pk_bf16(v0[2], v0[3]); w.z = cvt_pk_bf16(v1[0], v1[1]); w.w = cvt_pk_bf16(v1[2], v1[3]); *(u32x4*)(outb + off + bj * HALF) = w; }
                    s += (v0[0] * v0[0] + v0[1] * v0[1]) + (v0[2] * v0[2] + v0[3] * v0[3]) + (v1[0] * v1[0] + v1[1] * v1[1]) + (v1[2] * v1[2] + v1[3] * v1[3]); }
                s += __shfl_xor(s, 16); s += __shfl_xor(s, 32);
                if (fq == 0) ssq[(size_t)row * 16 + u.pn * 4 + wc] = s;
                asm volatile("" ::: "memory"); }
    }
};

template <class Epi, class Sched, bool ALIGN_EPI = false, bool SP2 = false>
__device__ __forceinline__ void gemm_phase(PG8_LAS unsigned char* lds, const Gemm g, const Sched& S, const Epi& E) {
    const int tid = threadIdx.x, wid = __builtin_amdgcn_readfirstlane(tid >> 6), lane = tid & 63, wr = wid >> 2, wc = wid & 3, fr = lane & 15, fq = lane >> 4;
    const int K = g.K, nt = K / BK;
    unsigned voffA[2], voffB[2];
#pragma unroll
    for (int i = 0; i < 2; ++i) { int R, C; stage_rc(tid * 16 + i * 8192, R, C); const int Rb = Epi::PERM ? ((R & ~31) + perm32(R & 31)) : R;
        voffA[i] = (unsigned)(R * K + C) * 2u; voffB[i] = (unsigned)(Rb * K + C) * 2u; }
    const size_t kstep = (size_t)(BK * 2);
    const size_t hstep = (size_t)HALF * K * 2;
    const size_t tstep = 2 * hstep;
    const unsigned ldsw = (unsigned)wid * 1024u;
    const int aoff = lds_byte(wr * 64 + fr, fq * 8), boff = lds_byte(wc * 32 + fr, fq * 8);
#define PG8_SA(b, h) (((b) * 2 + (h)) * HTB)
#define PG8_SB(b, h) ((4 + (b) * 2 + (h)) * HTB)
#define PG8_STAGE(bufoff, gbase, voff) do { _Pragma("unroll") for (int _i = 0; _i < 2; ++_i) \
        __builtin_amdgcn_global_load_lds((const unsigned*)((const char*)(gbase) + (voff)[_i]), (PG8_LAS unsigned*)(lds + (bufoff) + ldsw + _i * 8192), 16, 0, 0); } while (0)
#define PG8_LDA(dst, b, h) do { _Pragma("unroll") for (int m = 0; m < 4; ++m) _Pragma("unroll") for (int k = 0; k < 2; ++k) dst[m][k] = *(const PG8_LAS bf16x8*)(lds + PG8_SA(b, h) + aoff + m * 2048 + k * 1024); } while (0)
#define PG8_LDB(dst, b, h) do { _Pragma("unroll") for (int n = 0; n < 2; ++n) _Pragma("unroll") for (int k = 0; k < 2; ++k) dst[n][k] = *(const PG8_LAS bf16x8*)(lds + PG8_SB(b, h) + boff + n * 2048 + k * 1024); } while (0)
#define PG8_MMA(ai, bj, At, Bt) do { __builtin_amdgcn_s_setprio(1); _Pragma("unroll") for (int m = 0; m < 4; ++m) _Pragma("unroll") for (int n = 0; n < 2; ++n) _Pragma("unroll") for (int k = 0; k < 2; ++k) \
        acc[ai][bj][m][n] = __builtin_amdgcn_mfma_f32_16x16x32_bf16(Bt[n][k], At[m][k], acc[ai][bj][m][n], 0, 0, 0); __builtin_amdgcn_s_setprio(0); } while (0)
#define PG8_WAIT_V(n) asm volatile("s_waitcnt vmcnt(" #n ")" ::: "memory")
#define PG8_WAIT_L(n) asm volatile("s_waitcnt lgkmcnt(" #n ")" ::: "memory")
#define PG8_BAR __builtin_amdgcn_s_barrier()
#define PG8_SCHED __builtin_amdgcn_sched_barrier(0)
    Unit cur, nxt; int ui = 0;
    if (!S.next(0, cur)) return;
    f32x4 acc[2][2][4][2];
#pragma unroll
    for (int a = 0; a < 2; ++a)
#pragma unroll
        for (int b = 0; b < 2; ++b)
#pragma unroll
            for (int m = 0; m < 4; ++m)
#pragma unroll
                for (int n = 0; n < 2; ++n) acc[a][b][m][n] = (f32x4){0.f, 0.f, 0.f, 0.f};
    bf16x8 At[4][2], B0[2][2], B1[2][2];
    const char* cA = (const char*)g.A + (size_t)cur.pm * tstep; const char* cB = (const char*)g.Bt + (size_t)cur.pn * tstep;
    S.a_ready(cur);
    if constexpr (SP2) {
        PG8_STAGE(PG8_SB(0, 0), cB, voffB); PG8_STAGE(PG8_SB(0, 1), cB + hstep, voffB); PG8_STAGE(PG8_SA(0, 0), cA, voffA); PG8_STAGE(PG8_SA(0, 1), cA + hstep, voffA);
        if (wr == 1) PG8_BAR;
        PG8_WAIT_V(2); PG8_BAR;
        PG8_STAGE(PG8_SB(1, 0), cB + kstep, voffB); PG8_STAGE(PG8_SA(1, 0), cA + kstep, voffA); PG8_STAGE(PG8_SB(1, 1), cB + hstep + kstep, voffB);
        PG8_WAIT_V(6); PG8_BAR;
    } else {
        PG8_STAGE(PG8_SB(0, 0), cB, voffB); PG8_STAGE(PG8_SA(0, 0), cA, voffA); PG8_STAGE(PG8_SB(0, 1), cB + hstep, voffB); PG8_STAGE(PG8_SA(0, 1), cA + hstep, voffA);
        if (wr == 1) PG8_BAR;
        PG8_WAIT_V(4); PG8_BAR;
        PG8_STAGE(PG8_SB(1, 0), cB + kstep, voffB); PG8_STAGE(PG8_SA(1, 0), cA + kstep, voffA); PG8_STAGE(PG8_SB(1, 1), cB + hstep + kstep, voffB);
        PG8_WAIT_V(6); PG8_BAR;
    }
    for (;;) {
        const bool has_next = S.next(ui + 1, nxt);
        const char* nA = has_next ? (const char*)g.A + (size_t)nxt.pm * tstep : cA; const char* nB = has_next ? (const char*)g.Bt + (size_t)nxt.pn * tstep : cB;
        for (int t = 0; t < nt; t += 2) {
            const bool last = (t == nt - 2);
            const char* a1 = cA + (size_t)(t + 1) * kstep;
            const char* a2 = last ? nA : cA + (size_t)(t + 2) * kstep; const char* b2 = last ? nB : cB + (size_t)(t + 2) * kstep;
            const char* a3 = a2 + kstep; const char* b3 = b2 + kstep;
            if (last && has_next) S.a_ready(nxt);
            if constexpr (SP2) {
            PG8_LDB(B0, 0, 0); PG8_LDB(B1, 0, 1); PG8_SCHED; PG8_LDA(At, 0, 0); PG8_STAGE(PG8_SA(1, 1), a1 + hstep, voffA);
            PG8_WAIT_V(8); PG8_WAIT_L(0); PG8_BAR; PG8_MMA(0, 0, At, B0); PG8_MMA(0, 1, At, B1); PG8_BAR; PG8_SCHED;
            PG8_LDA(At, 0, 1); PG8_STAGE(PG8_SB(0, 0), b2, voffB); PG8_STAGE(PG8_SB(0, 1), b2 + hstep, voffB); PG8_STAGE(PG8_SA(0, 0), a2, voffA);
            PG8_WAIT_V(8); PG8_WAIT_L(0); PG8_BAR; PG8_MMA(1, 0, At, B0); PG8_MMA(1, 1, At, B1); PG8_BAR; PG8_SCHED;
            PG8_LDB(B0, 1, 0); PG8_LDB(B1, 1, 1); PG8_SCHED; PG8_LDA(At, 1, 0); PG8_STAGE(PG8_SA(0, 1), a2 + hstep, voffA);
            PG8_WAIT_V(8); PG8_WAIT_L(0); PG8_BAR; PG8_MMA(0, 0, At, B0); PG8_MMA(0, 1, At, B1); PG8_BAR; PG8_SCHED;
            PG8_LDA(At, 1, 1); PG8_STAGE(PG8_SB(1, 0), b3, voffB); PG8_STAGE(PG8_SB(1, 1), b3 + hstep, voffB); PG8_STAGE(PG8_SA(1, 0), a3, voffA);
            PG8_WAIT_V(8); PG8_WAIT_L(0); PG8_BAR; PG8_MMA(1, 0, At, B0); PG8_MMA(1, 1, At, B1); PG8_BAR; PG8_SCHED;
            } else {
            PG8_LDB(B0, 0, 0); PG8_SCHED; PG8_LDA(At, 0, 0); PG8_STAGE(PG8_SA(1, 1), a1 + hstep, voffA);
            PG8_WAIT_L(8); PG8_BAR; PG8_WAIT_L(0); PG8_MMA(0, 0, At, B0); PG8_BAR; PG8_SCHED;
            PG8_LDB(B1, 0, 1); PG8_STAGE(PG8_SB(0, 0), b2, voffB);
            PG8_BAR; PG8_WAIT_L(0); PG8_MMA(0, 1, At, B1); PG8_BAR;
            PG8_LDA(At, 0, 1); PG8_STAGE(PG8_SA(0, 0), a2, voffA);
            PG8_BAR; PG8_WAIT_L(0); PG8_MMA(1, 0, At, B0); PG8_BAR; PG8_SCHED;
            PG8_STAGE(PG8_SB(0, 1), b2 + hstep, voffB);
            PG8_WAIT_V(6); PG8_BAR; PG8_MMA(1, 1, At, B1); PG8_BAR;
            PG8_LDB(B0, 1, 0); PG8_SCHED; PG8_LDA(At, 1, 0); PG8_STAGE(PG8_SA(0, 1), a2 + hstep, voffA);
            PG8_WAIT_L(8); PG8_BAR; PG8_WAIT_L(0); PG8_MMA(0, 0, At, B0); PG8_BAR; PG8_SCHED;
            PG8_LDB(B1, 1, 1); PG8_STAGE(PG8_SB(1, 0), b3, voffB);
            PG8_BAR; PG8_WAIT_L(0); PG8_MMA(0, 1, At, B1); PG8_BAR;
            PG8_LDA(At, 1, 1); PG8_STAGE(PG8_SA(1, 0), a3, voffA);
            PG8_BAR; PG8_WAIT_L(0); PG8_MMA(1, 0, At, B0); PG8_BAR; PG8_SCHED;
            PG8_STAGE(PG8_SB(1, 1), b3 + hstep, voffB);
            PG8_WAIT_V(6); PG8_BAR; PG8_MMA(1, 1, At, B1); PG8_BAR;
            }
        }
        if constexpr (ALIGN_EPI) { if (wr == 0) PG8_BAR; }
        if constexpr (!Epi::AFTER_DRAIN) { E(acc, cur, wr, wc, fr, fq); S.done(cur); }
        if (!has_next) break;
#pragma unroll
        for (int a = 0; a < 2; ++a)
#pragma unroll
            for (int b = 0; b < 2; ++b)
#pragma unroll
                for (int m = 0; m < 4; ++m)
#pragma unroll
                    for (int n = 0; n < 2; ++n) acc[a][b][m][n] = (f32x4){0.f, 0.f, 0.f, 0.f};
        cur = nxt; cA = nA; cB = nB; ++ui;
        if constexpr (ALIGN_EPI) { if (wr == 1) PG8_BAR; }
    }
    PG8_WAIT_V(0);
    if constexpr (!ALIGN_EPI) { if (wr == 0) PG8_BAR; }
    PG8_BAR;
    if constexpr (Epi::AFTER_DRAIN) { E.fused(acc, cur, wr, wc, fr, fq, lds, wid, lane); S.done(cur); }
#undef PG8_SA
#undef PG8_SB
#undef PG8_STAGE
#undef PG8_LDA
#undef PG8_LDB
#undef PG8_MMA
#undef PG8_WAIT_V
#undef PG8_WAIT_L
#undef PG8_BAR
#undef PG8_SCHED
}
}

#include <hip/hip_cooperative_groups.h>
namespace cg = cooperative_groups;

#define LAS __attribute__((address_space(3)))
typedef unsigned short bf16;
typedef unsigned v4u __attribute__((ext_vector_type(4)));
typedef unsigned v2u __attribute__((ext_vector_type(2)));
typedef float f32x4 __attribute__((ext_vector_type(4)));
typedef short bf16x8 __attribute__((ext_vector_type(8)));
typedef short s16x4 __attribute__((ext_vector_type(4)));

constexpr int NWAVES = 8, NT = NWAVES * 64;
constexpr int BATCH = 4, SEQ = 4096, D = 1024, M = BATCH * SEQ, FF = 4096, NH = 16, HD = 64, GW = 64, ROWS = 64, KH = 8, WW = 16;
constexpr size_t MiB = 1u << 20;
constexpr size_t WS_BAR = 0;
constexpr size_t CTL_ZERO_BYTES = 65536;
constexpr int BARST_OFF = 151552;
constexpr size_t WS_SSQ = 1 * MiB;
constexpr size_t WS_WIN = 4 * MiB, WS_WOUT = 10 * MiB, WS_WQKV = 12 * MiB, WS_WO = 18 * MiB, WS_WUP0 = 20 * MiB, WS_WUP1 = 28 * MiB, WS_WDN0 = 36 * MiB, WS_WDN1 = 44 * MiB;
constexpr size_t WS_XB = 52 * MiB;
constexpr size_t WS_U = 84 * MiB;
constexpr size_t WS_Y = 180 * MiB;
constexpr size_t WS_A = 84 * MiB;
constexpr size_t WS_END = 212 * MiB;
constexpr int LDS_BYTES = 152576;

__device__ __forceinline__ unsigned f2bf(float f) { unsigned u = __builtin_bit_cast(unsigned, f); return (u + 0x7fffu + ((u >> 16) & 1u)) >> 16; }
__device__ __forceinline__ unsigned pk2(float lo, float hi) { return f2bf(lo) | (f2bf(hi) << 16); }
__device__ __forceinline__ float bf_lo(unsigned w) { return __builtin_bit_cast(float, w << 16); }
__device__ __forceinline__ float bf_hi(unsigned w) { return __builtin_bit_cast(float, w & 0xffff0000u); }
#define LDS_WAIT() asm volatile("s_waitcnt lgkmcnt(0)" ::: "memory")

__device__ __forceinline__ float wave_sum(float v) {
#pragma unroll
    for (int o = 1; o < 64; o <<= 1) v += __shfl_xor(v, o);
    return v;
}

__device__ __forceinline__ void p0_transpose_item(const float* W, int K, int N, bf16* WT, const float* g, LAS float* scr, int item, int lane) {
    const int nblk = N / 32, kb = item / nblk, nb = item % nblk, k0 = 64 * kb, n0 = 32 * nb;
#pragma unroll 8
    for (int i = 0; i < 32; ++i) { const int kk = 2 * i + (lane >> 5); float w = W[(size_t)(k0 + kk) * N + n0 + (lane & 31)]; if (g) w *= g[k0 + kk]; scr[kk * 33 + (lane & 31)] = w; }
    LDS_WAIT(); asm volatile("" ::: "memory");
    const int c = lane & 7;
#pragma unroll
    for (int j = 0; j < 4; ++j) { const int n = (lane >> 3) + 8 * j; const LAS float* s = scr + (8 * c) * 33 + n;
        v4u o; o.x = pk2(s[0 * 33], s[1 * 33]); o.y = pk2(s[2 * 33], s[3 * 33]); o.z = pk2(s[4 * 33], s[5 * 33]); o.w = pk2(s[6 * 33], s[7 * 33]);
        *(v4u*)(WT + (size_t)(n0 + n) * K + k0 + 8 * c) = o; }
    LDS_WAIT(); asm volatile("" ::: "memory");
}

#define XB_TMO      128
#define XB_XCNT(j)  (256  + 64 * (j))
#define XB_XSUB(j)  (1280 + 64 * (j))
#define XB_XGEN(j)  (2304 + 64 * (j))
#define XB_TOP      3328
#define XB_TOPGEN   3392
#define XCD_BAR_WORDS 3456
#define XB_SPIN_CAP (1u << 18)

__device__ __forceinline__ unsigned xb_ld(unsigned* p)              { return __hip_atomic_load(p, __ATOMIC_RELAXED, __HIP_MEMORY_SCOPE_AGENT); }
__device__ __forceinline__ unsigned xb_add(unsigned* p, unsigned v) { return __hip_atomic_fetch_add(p, v, __ATOMIC_RELAXED, __HIP_MEMORY_SCOPE_AGENT); }
__device__ __forceinline__ unsigned xb_xcc_id() { return (unsigned)__builtin_amdgcn_s_getreg((3 << 11) | 20) & 0xFu; }
#define XB_SPIN(cond, bar) do { unsigned _sp = 0; while (cond) { __builtin_amdgcn_s_sleep(1); \
    if ((++_sp & 255u) == 0u) { if (xb_ld(&(bar)[XB_TMO])) break; if (_sp > XB_SPIN_CAP) { atomicAdd(&(bar)[XB_TMO], 1u); break; } } } } while (0)

struct XcdBarrier {
    unsigned* bar; unsigned x;
    volatile LAS unsigned* st;
};

__device__ __forceinline__ XcdBarrier xcd_barrier_post(unsigned* bar, volatile LAS unsigned* st) {
    XcdBarrier b; b.bar = bar; b.x = xb_xcc_id(); b.st = st;
    if (threadIdx.x == 0) (void)xb_add(&bar[XB_XCNT(b.x)], 1u);
    return b;
}
__device__ __forceinline__ void xcd_barrier_complete(unsigned* bar, unsigned x, unsigned& nloc, unsigned& nx) {
    const unsigned G = gridDim.x * gridDim.y * gridDim.z;
    unsigned sum, cnt, mine, sp = 0u;
    for (;;) {
        sum = 0u; cnt = 0u; mine = 0u;
#pragma unroll
        for (unsigned j = 0; j < 16; ++j) { const unsigned c = xb_ld(&bar[XB_XCNT(j)]); sum += c; cnt += (c > 0u) ? 1u : 0u; mine = (j == x) ? c : mine; }
        if (sum == G) break;
        __builtin_amdgcn_s_sleep(1);
        if ((++sp & 255u) == 0u) { if (xb_ld(&bar[XB_TMO])) break; if (sp > XB_SPIN_CAP) { atomicAdd(&bar[XB_TMO], 1u); break; } }
    }
    nloc = mine > 0u ? mine : 1u; nx = cnt > 0u ? cnt : 1u;
}

__device__ __forceinline__ void xcd_barrier(const XcdBarrier& b) {
    asm volatile("s_waitcnt vmcnt(0)" ::: "memory");
    __syncthreads();
    if (threadIdx.x == 0) {
        unsigned* bar = b.bar;
        __builtin_amdgcn_s_waitcnt(0);
        unsigned nloc = b.st[0], nx = b.st[1];
        if (nloc == 0u) { xcd_barrier_complete(bar, b.x, nloc, nx); b.st[0] = nloc; b.st[1] = nx; }
        const unsigned old = xb_add(&bar[XB_XSUB(b.x)], 1u);
        const unsigned gen = old / nloc;
        if (old + 1u == (gen + 1u) * nloc) {
            __builtin_amdgcn_fence(__ATOMIC_RELEASE, "agent");
            asm volatile("s_waitcnt vmcnt(0)" ::: "memory");
            const unsigned og = xb_add(&bar[XB_TOP], 1u);
            const unsigned tg = og / nx;
            if (og + 1u == (tg + 1u) * nx) xb_add(&bar[XB_TOPGEN], 1u);
            else XB_SPIN(xb_ld(&bar[XB_TOPGEN]) == tg, bar);
            __builtin_amdgcn_fence(__ATOMIC_ACQUIRE, "agent");
            xb_add(&bar[XB_XGEN(b.x)], 1u);
            asm volatile("s_waitcnt vmcnt(0)" ::: "memory");
        } else {
            XB_SPIN(xb_ld(&bar[XB_XGEN(b.x)]) == gen, bar);
            __builtin_amdgcn_fence(__ATOMIC_ACQUIRE, "agent");
            asm volatile("s_waitcnt vmcnt(0)" ::: "memory");
        }
    }
    __syncthreads();
}

struct Args {
    const float* x; const float* norm_mix; const float* conv_w_in; const float* conv_w; const float* conv_w_out; const float* attn_w_qkv; const float* attn_rpb; const float* attn_w_o;
    const float* norm_mlp; const float* mlp_w_up; const float* mlp_w_down; const float* norm_final; float* out; unsigned char* ws; int use_cg_sync; int pad;
};

__device__ __forceinline__ void p0_prologue(const Args& a, LAS unsigned char* lds, int gw, int NGW, int wave, int lane) {
    LAS float* scr = (LAS float*)(lds + wave * 16384);
    unsigned char* ws = a.ws;
    constexpr int I_IN = 16 * 96, I_SQ = 16 * 32, I_UP = 16 * 128, I_DN = 64 * 32;
    constexpr int NITEMS = 2 * I_IN + 2 * I_SQ + 2 * I_UP + 2 * I_DN;
    for (int it = gw; it < NITEMS; it += NGW) {
        int r = it;
        if (r < I_IN) { p0_transpose_item(a.conv_w_in, D, 3 * D, (bf16*)(ws + WS_WIN), a.norm_mix, scr, r, lane); continue; } r -= I_IN;
        if (r < I_IN) { p0_transpose_item(a.attn_w_qkv, D, 3 * D, (bf16*)(ws + WS_WQKV), a.norm_mix + D, scr, r, lane); continue; } r -= I_IN;
        if (r < I_SQ) { p0_transpose_item(a.conv_w_out, D, D, (bf16*)(ws + WS_WOUT), nullptr, scr, r, lane); continue; } r -= I_SQ;
        if (r < I_SQ) { p0_transpose_item(a.attn_w_o, D, D, (bf16*)(ws + WS_WO), nullptr, scr, r, lane); continue; } r -= I_SQ;
        if (r < I_UP) { p0_transpose_item(a.mlp_w_up, D, FF, (bf16*)(ws + WS_WUP0), a.norm_mlp, scr, r, lane); continue; } r -= I_UP;
        if (r < I_UP) { p0_transpose_item(a.mlp_w_up + (size_t)D * FF, D, FF, (bf16*)(ws + WS_WUP1), a.norm_mlp + D, scr, r, lane); continue; } r -= I_UP;
        if (r < I_DN) { p0_transpose_item(a.mlp_w_down, FF, D, (bf16*)(ws + WS_WDN0), nullptr, scr, r, lane); continue; } r -= I_DN;
        p0_transpose_item(a.mlp_w_down + (size_t)FF * D, FF, D, (bf16*)(ws + WS_WDN1), nullptr, scr, r, lane);
    }
    bf16* XB = (bf16*)(ws + WS_XB); float* SSQ = (float*)(ws + WS_SSQ);
    for (int m = gw; m < M; m += NGW) {
        const f32x4* xr = (const f32x4*)(a.x + (size_t)m * D) + lane; f32x4 v[4]; float s = 0.f;
#pragma unroll
        for (int j = 0; j < 4; ++j) { v[j] = xr[64 * j]; s += (v[j].x * v[j].x + v[j].y * v[j].y) + (v[j].z * v[j].z + v[j].w * v[j].w); }
        s = wave_sum(s);
        v2u* o8 = (v2u*)(XB + (size_t)m * D) + lane;
#pragma unroll
        for (int j = 0; j < 4; ++j) { v2u o; o.x = pk2(v[j].x, v[j].y); o.y = pk2(v[j].z, v[j].w); o8[64 * j] = o; }
        if (lane < 16) SSQ[(size_t)m * 16 + lane] = (lane == 0) ? s : 0.f;
    }
}

__device__ __forceinline__ void conv_phase(const Args& a, int gw, int NGW, int lane) {
    const bf16* U = (const bf16*)(a.ws + WS_U); bf16* Y = (bf16*)(a.ws + WS_Y);
    constexpr int TCH = 16, NTASK = (M / TCH) * 2;
    for (int task = gw; task < NTASK; task += NGW) {
        const int ch = task >> 1, hf = task & 1, t0 = ch * TCH, d0 = hf * 512 + lane * 8;
        float w0[8], w1[8], w2[8];
#pragma unroll
        for (int e = 0; e < 8; ++e) { w0[e] = a.conv_w[d0 + e]; w1[e] = a.conv_w[D + d0 + e]; w2[e] = a.conv_w[2 * D + d0 + e]; }
        float zp[8], zc[8], zn[8];
        auto loadz = [&](int t, float* z) {
            const v4u c = *(const v4u*)(U + (size_t)t * (3 * D) + D + d0), v = *(const v4u*)(U + (size_t)t * (3 * D) + 2 * D + d0);
            z[0] = bf_lo(c.x) * bf_lo(v.x); z[1] = bf_hi(c.x) * bf_hi(v.x); z[2] = bf_lo(c.y) * bf_lo(v.y); z[3] = bf_hi(c.y) * bf_hi(v.y);
            z[4] = bf_lo(c.z) * bf_lo(v.z); z[5] = bf_hi(c.z) * bf_hi(v.z); z[6] = bf_lo(c.w) * bf_lo(v.w); z[7] = bf_hi(c.w) * bf_hi(v.w); };
        if ((t0 & (SEQ - 1)) == 0) {
#pragma unroll
            for (int e = 0; e < 8; ++e) zp[e] = 0.f; } else loadz(t0 - 1, zp);
        loadz(t0, zc);
        for (int i = 0; i < TCH; ++i) {
            const int t = t0 + i;
            if (((t + 1) & (SEQ - 1)) == 0) {
#pragma unroll
                for (int e = 0; e < 8; ++e) zn[e] = 0.f; } else loadz(t + 1, zn);
            const v4u bb = *(const v4u*)(U + (size_t)t * (3 * D) + d0);
            float bv[8] = {bf_lo(bb.x), bf_hi(bb.x), bf_lo(bb.y), bf_hi(bb.y), bf_lo(bb.z), bf_hi(bb.z), bf_lo(bb.w), bf_hi(bb.w)};
            float y[8];
#pragma unroll
            for (int e = 0; e < 8; ++e) y[e] = bv[e] * (w0[e] * zp[e] + w1[e] * zc[e] + w2[e] * zn[e]);
            v4u o; o.x = pk2(y[0], y[1]); o.y = pk2(y[2], y[3]); o.z = pk2(y[4], y[5]); o.w = pk2(y[6], y[7]);
            *(v4u*)(Y + (size_t)t * D + d0) = o;
#pragma unroll
            for (int e = 0; e < 8; ++e) { zp[e] = zc[e]; zc[e] = zn[e]; }
        }
    }
}

constexpr int AT_K = 0, AT_V = 73728, AT_B = 147456;
#define LBAR() do { asm volatile("s_waitcnt lgkmcnt(0)" ::: "memory"); __builtin_amdgcn_s_barrier(); asm volatile("" ::: "memory"); } while (0)
__device__ __forceinline__ int swz(int col) { return ((col >> 1) & 1) | (((col >> 3) & 3) << 1); }
__device__ __forceinline__ int rstart(int r) { return min(max(r - KH / 2, 0), ROWS - KH); }
__device__ __forceinline__ void attn_phase(const Args& a, LAS unsigned char* lds, int G, int bid, int tid) {
    const bf16* QKV = (const bf16*)(a.ws + WS_U); bf16* Y = (bf16*)(a.ws + WS_Y);
    LAS unsigned char* Kl = lds + AT_K; LAS unsigned char* Vl = lds + AT_V; LAS float* Bl = (LAS float*)(lds + AT_B);
    const int wave = __builtin_amdgcn_readfirstlane(tid >> 6), lane = tid & 63, g = lane >> 4, qi = lane & 15;
    const int j = wave & 3, wr = wave >> 2;
    const int c0 = (j == 0) ? 0 : (j == 1) ? 8 : (j == 2) ? 24 : 32;
    const int c = 16 * j + qi, cs = min(max(c - WW / 2, 0), GW - WW);
    int baddr[8];
#pragma unroll
    for (int T = 0; T < 2; ++T)
#pragma unroll
        for (int e = 0; e < 4; ++e) { const int kcol = c0 + 8 * g + 4 * T + e; const bool ok = (kcol >= cs) && (kcol < cs + WW); baddr[T * 4 + e] = AT_B + (ok ? (kcol - c + 15) : 31) * 4; }
    const int lcol = tid >> 3, lchunk = tid & 7, loff = (lcol << 7) + ((lchunk ^ swz(lcol)) << 4);
    const int kcolA = c0 + 8 * (qi >> 2) + (qi & 3);
    const int vq = qi >> 2, vp = qi & 3, vcol = c0 + 8 * g + vq, vsw = swz(vcol);
    const float SC = 0.125f * 1.4426950408889634f;
    for (int st = bid; st < BATCH * NH * 4; st += G) {
        const int b = st >> 6, h = (st >> 2) & 15, seg = st & 3, r0 = seg * 16;
        const bf16* kvsrc = QKV + ((size_t)b * SEQ + lcol) * (3 * D) + D + h * HD + lchunk * 8;
        __syncthreads();
        { const int row = tid >> 5, col = tid & 31; Bl[tid] = (row < 15 && col < 31) ? a.attn_rpb[h * 465 + row * 31 + col] * 1.4426950408889634f : -INFINITY; }
        int hi = rstart(r0 + 1) + 7;
        { const int lo = rstart(r0);
#pragma unroll
            for (int bb = 0; bb < 2; ++bb) { v4u kk[5], vv[5];
#pragma unroll
                for (int i = 0; i < 5; ++i) { const int row = lo + bb * 5 + i; if (row <= hi) { const bf16* p = kvsrc + (size_t)row * (GW * 3 * D); kk[i] = *(const v4u*)p; vv[i] = *(const v4u*)(p + D); } }
#pragma unroll
                for (int i = 0; i < 5; ++i) { const int row = lo + bb * 5 + i; if (row <= hi) { const int off = (row % 9) * 8192 + loff; *(LAS v4u*)(Kl + off) = kk[i]; *(LAS v4u*)(Vl + off) = vv[i]; } } } }
        v4u pk0, pv0, pk1, pv1; int npre = 0;
        pk0 = pv0 = pk1 = pv1 = (v4u){0u, 0u, 0u, 0u};
        bf16x8 q0, q1;
        { const size_t qtok = (size_t)b * SEQ + (r0 + wr) * GW + c; q0 = *(const bf16x8*)(QKV + qtok * (3 * D) + h * HD + g * 8); q1 = *(const bf16x8*)(QKV + qtok * (3 * D) + h * HD + 32 + g * 8); }
        for (int p = 0; p < 8; ++p) {
            const int r = r0 + 2 * p;
            if (p > 0) {
                LBAR();
                if (npre > 0) { const int off = ((hi + 1) % 9) * 8192 + loff; *(LAS v4u*)(Kl + off) = pk0; *(LAS v4u*)(Vl + off) = pv0; }
                if (npre > 1) { const int off = ((hi + 2) % 9) * 8192 + loff; *(LAS v4u*)(Kl + off) = pk1; *(LAS v4u*)(Vl + off) = pv1; }
                hi += npre;
            }
            LBAR();
            bf16x8 q0n = q0, q1n = q1;
            if (p < 7) {
                npre = rstart(r + 3) + 7 - hi;
                if (npre > 0) { const bf16* pp = kvsrc + (size_t)(hi + 1) * (GW * 3 * D); pk0 = *(const v4u*)pp; pv0 = *(const v4u*)(pp + D); }
                if (npre > 1) { const bf16* pp = kvsrc + (size_t)(hi + 2) * (GW * 3 * D); pk1 = *(const v4u*)pp; pv1 = *(const v4u*)(pp + D); }
                const size_t qtok = (size_t)b * SEQ + (r + 2 + wr) * GW + c; q0n = *(const bf16x8*)(QKV + qtok * (3 * D) + h * HD + g * 8); q1n = *(const bf16x8*)(QKV + qtok * (3 * D) + h * HD + 32 + g * 8);
            }
            {
                const int rr = r + wr, s = rstart(rr); const int sl = s % 9;
                const int roffb = (s - rr + 7) * 128;
                f32x4 sc[8][2];
                float mx = -INFINITY;
#pragma unroll
                for (int i = 0; i < 8; ++i) {
                    const int slot = (sl + i >= 9) ? sl + i - 9 : sl + i;
#pragma unroll
                    for (int T = 0; T < 2; ++T) {
                        const int kc = kcolA + 4 * T; const int base = slot * 8192 + (kc << 7), sw = swz(kc);
                        const bf16x8 k0 = *(const LAS bf16x8*)(Kl + base + ((g ^ sw) << 4)), k1 = *(const LAS bf16x8*)(Kl + base + (((4 + g) ^ sw) << 4));
                        f32x4 acc = (f32x4){0.f, 0.f, 0.f, 0.f};
                        acc = __builtin_amdgcn_mfma_f32_16x16x32_bf16(k0, q0, acc, 0, 0, 0);
                        acc = __builtin_amdgcn_mfma_f32_16x16x32_bf16(k1, q1, acc, 0, 0, 0);
#pragma unroll
                        for (int e = 0; e < 4; ++e) { const float bias = *(const LAS float*)(lds + baddr[T * 4 + e] + roffb + i * 128); const float v = acc[e] * SC + bias; acc[e] = v; mx = fmaxf(mx, v); }
                        sc[i][T] = acc;
                    }
                }
                mx = fmaxf(mx, __shfl_xor(mx, 16)); mx = fmaxf(mx, __shfl_xor(mx, 32));
                float sum = 0.f;
#pragma unroll
                for (int i = 0; i < 8; ++i)
#pragma unroll
                    for (int T = 0; T < 2; ++T)
#pragma unroll
                        for (int e = 0; e < 4; ++e) { const float pe = __builtin_amdgcn_exp2f(sc[i][T][e] - mx); sc[i][T][e] = pe; sum += pe; }
                sum += __shfl_xor(sum, 16); sum += __shfl_xor(sum, 32);
                f32x4 o[4];
#pragma unroll
                for (int dt = 0; dt < 4; ++dt) o[dt] = (f32x4){0.f, 0.f, 0.f, 0.f};
#pragma unroll
                for (int i = 0; i < 8; ++i) {
                    const int slot = (sl + i >= 9) ? sl + i - 9 : sl + i;
                    v4u pw; pw.x = pg8::cvt_pk_bf16(sc[i][0][0], sc[i][0][1]); pw.y = pg8::cvt_pk_bf16(sc[i][0][2], sc[i][0][3]); pw.z = pg8::cvt_pk_bf16(sc[i][1][0], sc[i][1][1]); pw.w = pg8::cvt_pk_bf16(sc[i][1][2], sc[i][1][3]);
                    const bf16x8 pf = __builtin_bit_cast(bf16x8, pw);
                    const int vbase = slot * 8192 + (vcol << 7) + (vp & 1) * 8;
#pragma unroll
                    for (int dt = 0; dt < 4; ++dt) {
                        const int ch = ((dt * 2 + (vp >> 1)) ^ vsw) << 4;
                        const s16x4 lo = __builtin_bit_cast(s16x4, __builtin_amdgcn_ds_read_tr16_b64_v4i16((LAS s16x4*)(Vl + vbase + ch)));
                        const s16x4 hi4 = __builtin_bit_cast(s16x4, __builtin_amdgcn_ds_read_tr16_b64_v4i16((LAS s16x4*)(Vl + vbase + ch + 512)));
                        bf16x8 vf; vf[0] = lo[0]; vf[1] = lo[1]; vf[2] = lo[2]; vf[3] = lo[3]; vf[4] = hi4[0]; vf[5] = hi4[1]; vf[6] = hi4[2]; vf[7] = hi4[3];
                        o[dt] = __builtin_amdgcn_mfma_f32_16x16x32_bf16(vf, pf, o[dt], 0, 0, 0);
                    }
                }
                const float inv = 1.0f / sum;
                bf16* yp = Y + ((size_t)b * SEQ + rr * GW + c) * D + h * HD + 4 * g;
#pragma unroll
                for (int dt = 0; dt < 4; ++dt) { v2u w; w.x = pg8::cvt_pk_bf16(o[dt][0] * inv, o[dt][1] * inv); w.y = pg8::cvt_pk_bf16(o[dt][2] * inv, o[dt][3] * inv); *(v2u*)(yp + dt * 16) = w; }
            }
            q0 = q0n; q1 = q1n;
        }
    }
}

__device__ __forceinline__ void final_norm(const Args& a, int gw, int NGW, int lane) {
    const float* SSQ = (const float*)(a.ws + WS_SSQ);
    f32x4 gv[4];
#pragma unroll
    for (int j = 0; j < 4; ++j) gv[j] = ((const f32x4*)a.norm_final)[lane + 64 * j];
    for (int m = gw; m < M; m += NGW) {
        const float rs = pg8::row_rstd(SSQ, m);
        f32x4* xr = (f32x4*)(a.out + (size_t)m * D) + lane;
#pragma unroll
        for (int j = 0; j < 4; ++j) { f32x4 v = xr[64 * j]; v = v * rs * gv[j]; xr[64 * j] = v; }
    }
}

__global__ void __launch_bounds__(NT) fwd_megakernel(Args a) {
    extern __shared__ __attribute__((aligned(16))) unsigned char lds_raw[];
    LAS unsigned char* lds = (LAS unsigned char*)lds_raw;
    cg::grid_group grid = cg::this_grid();
    const int tid = threadIdx.x, lane = tid & 63, wave = __builtin_amdgcn_readfirstlane(tid >> 6);
    const int G = gridDim.x, bid = blockIdx.x, gw = bid * NWAVES + wave, NGW = G * NWAVES;
    unsigned char* ws = a.ws;
    bf16* XB = (bf16*)(ws + WS_XB); bf16* U = (bf16*)(ws + WS_U); bf16* Y = (bf16*)(ws + WS_Y); bf16* A = (bf16*)(ws + WS_A); float* SSQ = (float*)(ws + WS_SSQ);

    if (tid < 2) ((volatile LAS unsigned*)(lds + BARST_OFF))[tid] = 0u;
    __syncthreads();
    const XcdBarrier bar = xcd_barrier_post((unsigned*)(ws + WS_BAR), (volatile LAS unsigned*)(lds + BARST_OFF));
    if (a.use_cg_sync) grid.sync();
    p0_prologue(a, lds, gw, NGW, wave, lane);
    xcd_barrier(bar);
    { pg8::Gemm g{XB, (const bf16*)(ws + WS_WIN), M, 3 * D, D}; pg8::StaticOrder S; S.init(M, 3 * D, G, bid); pg8::EpiScale<0> E{U, 3 * D, SSQ};
      pg8::gemm_phase<pg8::EpiScale<0>, pg8::StaticOrder, true, true>(lds, g, S, E); }
    xcd_barrier(bar);
    conv_phase(a, gw, NGW, lane);
    xcd_barrier(bar);
    { pg8::Gemm g{Y, (const bf16*)(ws + WS_WOUT), M, D, D}; pg8::StaticOrder S; S.init(M, D, G, bid); pg8::EpiResid E{a.x, nullptr, nullptr, XB, SSQ};
      pg8::gemm_phase<pg8::EpiResid, pg8::StaticOrder, true, true>(lds, g, S, E); }
    xcd_barrier(bar);
    { pg8::Gemm g{XB, (const bf16*)(ws + WS_WUP0), M, FF, D}; pg8::StaticOrder S; S.init(M, FF, G, bid); pg8::EpiScale<1> E{A, FF, SSQ};
      pg8::gemm_phase<pg8::EpiScale<1>, pg8::StaticOrder, true, true>(lds, g, S, E); }
    xcd_barrier(bar);
    { pg8::Gemm g{A, (const bf16*)(ws + WS_WDN0), M, D, FF}; pg8::StaticOrder S; S.init(M, D, G, bid); pg8::EpiResid E{nullptr, XB, nullptr, XB, SSQ};
      pg8::gemm_phase<pg8::EpiResid, pg8::StaticOrder, true, true>(lds, g, S, E); }
    xcd_barrier(bar);
    { pg8::Gemm g{XB, (const bf16*)(ws + WS_WQKV), M, 3 * D, D}; pg8::StaticOrder S; S.init(M, 3 * D, G, bid); pg8::EpiScale<0> E{U, 3 * D, SSQ};
      pg8::gemm_phase<pg8::EpiScale<0>, pg8::StaticOrder, true, true>(lds, g, S, E); }
    xcd_barrier(bar);
    attn_phase(a, lds, G, bid, tid);
    xcd_barrier(bar);
    { pg8::Gemm g{Y, (const bf16*)(ws + WS_WO), M, D, D}; pg8::StaticOrder S; S.init(M, D, G, bid); pg8::EpiResid E{nullptr, XB, nullptr, XB, SSQ};
      pg8::gemm_phase<pg8::EpiResid, pg8::StaticOrder, true, true>(lds, g, S, E); }
    xcd_barrier(bar);
    { pg8::Gemm g{XB, (const bf16*)(ws + WS_WUP1), M, FF, D}; pg8::StaticOrder S; S.init(M, FF, G, bid); pg8::EpiScale<1> E{A, FF, SSQ};
      pg8::gemm_phase<pg8::EpiScale<1>, pg8::StaticOrder, true, true>(lds, g, S, E); }
    xcd_barrier(bar);
    { pg8::Gemm g{A, (const bf16*)(ws + WS_WDN1), M, D, FF}; pg8::StaticOrder S; S.init(M, D, G, bid); pg8::EpiResid E{nullptr, XB, a.out, nullptr, SSQ};
      pg8::gemm_phase<pg8::EpiResid, pg8::StaticOrder, true, true>(lds, g, S, E); }
    xcd_barrier(bar);
    final_norm(a, gw, NGW, lane);
}

extern "C" void kernel_launch(void* const* d_in, const int* in_sizes, int n_in, void* d_out, int out_size, void* d_ws, size_t ws_size, hipStream_t stream) {
    static int grid = 0;
    if (grid == 0) {
        if (n_in != 12 || in_sizes[0] != M * D || out_size != M * D || ws_size < WS_END) { fprintf(stderr, "kernel_launch: unexpected shapes (n_in %d, in0 %d, out %d, ws %zu)\n", n_in, n_in > 0 ? in_sizes[0] : -1, out_size, ws_size); grid = -1; return; }
        int dev = 0, cus = 0, per_cu = 0;
        (void)hipGetDevice(&dev); (void)hipDeviceGetAttribute(&cus, hipDeviceAttributeMultiprocessorCount, dev);
        (void)hipFuncSetAttribute((const void*)fwd_megakernel, hipFuncAttributeMaxDynamicSharedMemorySize, LDS_BYTES);
        (void)hipOccupancyMaxActiveBlocksPerMultiprocessor(&per_cu, (const void*)fwd_megakernel, NT, LDS_BYTES);
        if (per_cu < 1) { fprintf(stderr, "kernel_launch: occupancy query says %d blocks per CU\n", per_cu); per_cu = 1; }
        (void)hipGetLastError();
        grid = cus * per_cu;
    }
    if (grid < 0) return;
    Args a{};
    a.x = (const float*)d_in[0]; a.norm_mix = (const float*)d_in[1]; a.conv_w_in = (const float*)d_in[2]; a.conv_w = (const float*)d_in[3]; a.conv_w_out = (const float*)d_in[4];
    a.attn_w_qkv = (const float*)d_in[5]; a.attn_rpb = (const float*)d_in[6]; a.attn_w_o = (const float*)d_in[7]; a.norm_mlp = (const float*)d_in[8]; a.mlp_w_up = (const float*)d_in[9];
    a.mlp_w_down = (const float*)d_in[10]; a.norm_final = (const float*)d_in[11]; a.out = (float*)d_out; a.ws = (unsigned char*)d_ws;
    a.use_cg_sync = 0; a.pad = 0;
    if (hipMemsetAsync((char*)d_ws + WS_BAR, 0, CTL_ZERO_BYTES, stream) != hipSuccess) { fprintf(stderr, "kernel_launch: hipMemsetAsync failed\n"); return; }
    void* args[] = {&a};
    hipError_t e = hipLaunchCooperativeKernel((const void*)fwd_megakernel, dim3(grid), dim3(NT), args, LDS_BYTES, stream);
    if (e != hipSuccess) fprintf(stderr, "kernel_launch: cooperative launch failed: %s (grid %d)\n", hipGetErrorString(e), grid);
}
```
